# Optimizing an MI355X kernel written in HIP

```python
import jax, jax.numpy as jnp
from jax import lax
import numpy as np

D_MODEL = 2048
BATCH = 8
SEQ = 4096
DEPTH = 4

N_EVEN = (DEPTH + 1) // 2
N_ODD = DEPTH // 2

MLA_HEADS = 8
QK_NOPE_DIM = 128
QK_ROPE_DIM = 64
QK_HEAD_DIM = QK_NOPE_DIM + QK_ROPE_DIM
V_HEAD_DIM = 128
Q_LORA_RANK = D_MODEL // 4
KV_LORA_RANK = D_MODEL // 4
ROPE_THETA = 10000.0
MLA_WIDTH = MLA_HEADS * V_HEAD_DIM
Q_BLOCK = 128

POOL_WINDOWS = (2, 4, 8, 16)
POOL_GROUPS = len(POOL_WINDOWS)
POOL_GROUP_DIM = D_MODEL // 8
POOL_WIDTH = POOL_GROUPS * POOL_GROUP_DIM

EVEN_IN_SIZES = (Q_LORA_RANK, KV_LORA_RANK, QK_ROPE_DIM, POOL_WIDTH)
EVEN_IN_DIM = sum(EVEN_IN_SIZES)
EVEN_MIX_DIM = MLA_WIDTH + POOL_WIDTH

CONV_WIDTH = 3
CONV_DIM = D_MODEL

D_FF = 4 * D_MODEL
RMS_EPS = 1e-6

kernel_name = "hybrid_mla_pool_shortconv_trunk"


def _rmsnorm(x, g):
    xf = x.astype(jnp.float32)
    y = xf * lax.rsqrt(jnp.mean(jnp.square(xf), axis=-1, keepdims=True) + RMS_EPS)
    return (y * g.astype(jnp.float32)).astype(x.dtype)


def _rope_tables(positions):
    inv_freq = 1.0 / (ROPE_THETA ** (jnp.arange(0, QK_ROPE_DIM, 2, dtype=jnp.float32) / QK_ROPE_DIM))
    ang = positions.astype(jnp.float32)[..., None] * inv_freq
    return jnp.cos(ang)[:, :, None, :], jnp.sin(ang)[:, :, None, :]


def _rope(x, cos, sin):
    xf = x.astype(jnp.float32)
    x1, x2 = jnp.split(xf, 2, axis=-1)
    return jnp.concatenate([x1 * cos - x2 * sin, x2 * cos + x1 * sin], axis=-1).astype(x.dtype)


def _causal_attention(q, k, v):
    B, S, H, Dh = q.shape
    Dv = v.shape[-1]
    n_blocks = S // Q_BLOCK
    scale = Dh ** -0.5
    qb = q.reshape(B, n_blocks, Q_BLOCK, H, Dh).transpose(1, 0, 2, 3, 4)
    key_pos = jnp.arange(S)
    neg = jnp.finfo(jnp.float32).min

    def one_block(args):
        q_blk, blk = args
        s = jnp.einsum('bqhd,bkhd->bhqk', q_blk, k, preferred_element_type=jnp.float32) * scale
        q_pos = blk * Q_BLOCK + jnp.arange(Q_BLOCK)
        s = jnp.where(key_pos[None, :] <= q_pos[:, None], s, neg)
        p = jax.nn.softmax(s, axis=-1).astype(v.dtype)
        return jnp.einsum('bhqk,bkhe->bqhe', p, v)

    out = lax.map(one_block, (qb, jnp.arange(n_blocks)))
    return out.transpose(1, 0, 2, 3, 4).reshape(B, S, H, Dv)


def _mla(c_q, c_kv, k_rope, cos, sin, q_a_g, kv_a_g, w_uq, w_ukv, q_norm_g, k_norm_g):
    B, S, _ = c_q.shape
    c_q = _rmsnorm(c_q, q_a_g)
    c_kv = _rmsnorm(c_kv, kv_a_g)
    q = (c_q @ w_uq).reshape(B, S, MLA_HEADS, QK_HEAD_DIM)
    kv = (c_kv @ w_ukv).reshape(B, S, MLA_HEADS, QK_NOPE_DIM + V_HEAD_DIM)
    k_nope, v = kv[..., :QK_NOPE_DIM], kv[..., QK_NOPE_DIM:]
    k_r = jnp.broadcast_to(k_rope[:, :, None, :], (B, S, MLA_HEADS, QK_ROPE_DIM))
    k = jnp.concatenate([k_nope, k_r], axis=-1)
    q = _rmsnorm(q, q_norm_g)
    k = _rmsnorm(k, k_norm_g)
    q = jnp.concatenate([q[..., :QK_NOPE_DIM], _rope(q[..., QK_NOPE_DIM:], cos, sin)], axis=-1)
    k = jnp.concatenate([k[..., :QK_NOPE_DIM], _rope(k[..., QK_NOPE_DIM:], cos, sin)], axis=-1)
    out = _causal_attention(q, k, v)
    return out.reshape(B, S, MLA_WIDTH)


def _pool_mixer(u, pool_w, pool_scale):
    B, S, _ = u.shape
    uf = u.astype(jnp.float32).reshape(B, S, POOL_GROUPS, POOL_GROUP_DIM)
    cs = jnp.pad(jnp.cumsum(uf, axis=1), ((0, 0), (1, 0), (0, 0), (0, 0)))
    t = jnp.arange(S)[:, None]
    w = jnp.array(POOL_WINDOWS, dtype=jnp.int32)[None, :]
    start = jnp.maximum(t + 1 - w, 0)
    count = jnp.minimum(t + 1, w).astype(jnp.float32)
    lagged = cs[:, start, jnp.arange(POOL_GROUPS)[None, :]]
    mean = (cs[:, 1:] - lagged) / count[None, :, :, None]
    pooled = (mean - uf).astype(u.dtype)
    y = jnp.einsum('bsgc,gcd->bsgd', pooled, pool_w)
    y = y * pool_scale.reshape(POOL_GROUPS, POOL_GROUP_DIM)
    return y.reshape(B, S, POOL_WIDTH)


def _short_conv(x_normed, w_in, conv_w, w_out):
    S = x_normed.shape[1]
    gate_b, gate_c, u = jnp.split(x_normed @ w_in, 3, axis=-1)
    v = gate_c * u
    v_pad = jnp.pad(v, ((0, 0), (CONV_WIDTH - 1, 0), (0, 0)))
    conv = conv_w[0] * v_pad[:, 0:S]
    for j in range(1, CONV_WIDTH):
        conv = conv + conv_w[j] * v_pad[:, j:j + S]
    return (gate_b * conv) @ w_out


def _mlp(h, w_up, w_down):
    return jnp.square(jax.nn.relu(h @ w_up)) @ w_down


def setup_inputs(seed: int = 0) -> dict:
    key = jax.random.key(seed)
    ks = jax.random.split(key, 20)
    D = D_MODEL

    def nrm(k, shape, fan_in):
        return jax.random.normal(k, shape, jnp.float32) * (fan_in ** -0.5)

    def gain(k, shape):
        return 1.0 + 0.02 * jax.random.normal(k, shape, jnp.float32)

    x = jax.random.normal(ks[0], (BATCH, SEQ, D), jnp.float32)
    positions = jnp.broadcast_to(jnp.arange(SEQ, dtype=jnp.int32)[None, :], (BATCH, SEQ))
    return {
        "x": x,
        "positions": positions,
        "mix_norm_g": gain(ks[1], (DEPTH, D)),
        "mlp_norm_g": gain(ks[2], (DEPTH, D)),
        "w_mlp_up": nrm(ks[3], (DEPTH, D, D_FF), D),
        "w_mlp_down": nrm(ks[4], (DEPTH, D_FF, D), D_FF),
        "even_w_in": nrm(ks[5], (N_EVEN, D, EVEN_IN_DIM), D),
        "even_q_a_norm_g": gain(ks[6], (N_EVEN, Q_LORA_RANK)),
        "even_kv_a_norm_g": gain(ks[7], (N_EVEN, KV_LORA_RANK)),
        "even_w_uq": nrm(ks[8], (N_EVEN, Q_LORA_RANK, MLA_HEADS * QK_HEAD_DIM), Q_LORA_RANK),
        "even_w_ukv": nrm(ks[9], (N_EVEN, KV_LORA_RANK, MLA_HEADS * (QK_NOPE_DIM + V_HEAD_DIM)), KV_LORA_RANK),
        "even_q_norm_g": gain(ks[10], (N_EVEN, QK_HEAD_DIM)),
        "even_k_norm_g": gain(ks[11], (N_EVEN, QK_HEAD_DIM)),
        "even_pool_w": nrm(ks[12], (N_EVEN, POOL_GROUPS, POOL_GROUP_DIM, POOL_GROUP_DIM), POOL_GROUP_DIM),
        "even_pool_scale": gain(ks[13], (N_EVEN, POOL_WIDTH)),
        "even_w_out": nrm(ks[14], (N_EVEN, EVEN_MIX_DIM, D), EVEN_MIX_DIM),
        "odd_w_in": nrm(ks[15], (N_ODD, D, 3 * CONV_DIM), D),
        "odd_conv_w": nrm(ks[16], (N_ODD, CONV_WIDTH, CONV_DIM), CONV_WIDTH),
        "odd_w_out": nrm(ks[17], (N_ODD, CONV_DIM, D), CONV_DIM),
    }


def reference(x, positions, mix_norm_g, mlp_norm_g, w_mlp_up, w_mlp_down,
              even_w_in, even_q_a_norm_g, even_kv_a_norm_g, even_w_uq, even_w_ukv,
              even_q_norm_g, even_k_norm_g, even_pool_w, even_pool_scale, even_w_out,
              odd_w_in, odd_conv_w, odd_w_out):
    cos, sin = _rope_tables(positions)
    split_at = list(np.cumsum(EVEN_IN_SIZES)[:-1])
    for layer in range(DEPTH):
        h = _rmsnorm(x, mix_norm_g[layer])
        if layer % 2 == 0:
            e = layer // 2
            c_q, c_kv, k_rope, u_pool = jnp.split(h @ even_w_in[e], split_at, axis=-1)
            a = _mla(c_q, c_kv, k_rope, cos, sin, even_q_a_norm_g[e], even_kv_a_norm_g[e],
                     even_w_uq[e], even_w_ukv[e], even_q_norm_g[e], even_k_norm_g[e])
            b = _pool_mixer(u_pool, even_pool_w[e], even_pool_scale[e])
            x = x + jnp.concatenate([a, b], axis=-1) @ even_w_out[e]
        else:
            o = layer // 2
            x = x + _short_conv(h, odd_w_in[o], odd_conv_w[o], odd_w_out[o])
        x = x + _mlp(_rmsnorm(x, mlp_norm_g[layer]), w_mlp_up[layer], w_mlp_down[layer])
    return x
```

```cpp
#include <hip/hip_runtime.h>
#include <hip/hip_cooperative_groups.h>
#include <cstdio>
#include <cstdint>
namespace cg = cooperative_groups;

#define LAS __attribute__((address_space(3)))
typedef unsigned short bf16_t;
typedef short bf16x8 __attribute__((ext_vector_type(8)));
typedef float f32x4 __attribute__((ext_vector_type(4)));
typedef float f32x16 __attribute__((ext_vector_type(16)));
typedef unsigned u32x4 __attribute__((ext_vector_type(4)));
typedef unsigned u32x2 __attribute__((ext_vector_type(2)));

constexpr int DM = 2048, BATCH = 8, SEQ = 4096, MROWS = BATCH * SEQ, FF = 8192;
constexpr int NIN_E = 2304;
constexpr float RMS_EPS = 1e-6f;
constexpr float QSCALE = 0.07216878364870322f * 1.4426950408889634f;

constexpr size_t MiB = 1u << 20;
constexpr size_t WS_SSQX = 1 * MiB;
constexpr size_t WS_SSQC = 5 * MiB;
constexpr size_t WS_ROPE = 8 * MiB;
constexpr size_t WS_W = 16 * MiB;
constexpr size_t W_UP = WS_W, W_DOWN = WS_W + 128 * MiB, W_INE = WS_W + 256 * MiB, W_UQ = WS_W + 274 * MiB, W_UKV = WS_W + 277 * MiB,
                 W_POOL = WS_W + 281 * MiB, W_OUTE = WS_W + 282 * MiB, W_INO = WS_W + 298 * MiB, W_OUTO = WS_W + 346 * MiB;
constexpr size_t WS_XB = 378 * MiB;
constexpr size_t WS_H = 506 * MiB;
constexpr size_t H_CU = WS_H, H_KROPE = WS_H, H_VT = WS_H + 368 * MiB, H_KR = WS_H + 128 * MiB, H_MIX = WS_H + 144 * MiB, H_QROPE = WS_H + 272 * MiB,
                 H_KV = WS_H + 304 * MiB, H_POOLED = WS_H + 432 * MiB, H_VB = WS_H, H_BG = WS_H + 128 * MiB, H_G = WS_H + 384 * MiB;
constexpr size_t WS_END = 1018 * MiB;

constexpr int LDS_BYTES = 163840;
#ifndef FP8_DOWN_MASK
#define FP8_DOWN_MASK 0
#endif
constexpr float F8_SCALE_H = 4.0f, F8_SCALE_W = 4096.0f, F8_UNSCALE = 1.0f / (4.0f * 4096.0f);
typedef int i32x4 __attribute__((ext_vector_type(4)));
typedef int i32x8 __attribute__((ext_vector_type(8)));
__device__ __forceinline__ unsigned pk4_fp8(float a, float b, float c, float d) {
    a = fminf(fmaxf(a, -448.f), 448.f); b = fminf(fmaxf(b, -448.f), 448.f); c = fminf(fmaxf(c, -448.f), 448.f); d = fminf(fmaxf(d, -448.f), 448.f);
    int r = 0; r = __builtin_amdgcn_cvt_pk_fp8_f32(a, b, r, false); r = __builtin_amdgcn_cvt_pk_fp8_f32(c, d, r, true); return (unsigned)r; }

__device__ __forceinline__ unsigned cvt_pk_bf16(float lo, float hi) { unsigned r; asm volatile("v_cvt_pk_bf16_f32 %0, %1, %2" : "=v"(r) : "v"(lo), "v"(hi)); return r; }
__device__ __forceinline__ float bf_lo(unsigned u) { return __uint_as_float(u << 16); }
__device__ __forceinline__ float bf_hi(unsigned u) { return __uint_as_float(u & 0xffff0000u); }

__device__ __forceinline__ int fresh_tid(int wv) {
    unsigned m = ~0u; asm volatile("" : "+s"(m));
    int t = wv * 64 + (int)__builtin_amdgcn_mbcnt_hi(m, __builtin_amdgcn_mbcnt_lo(m, 0u)); asm volatile("" : "+v"(t)); return t; }

__device__ __forceinline__ float sum_x16(float s) { auto r = __builtin_amdgcn_permlane16_swap(__float_as_uint(s), __float_as_uint(s), false, false); return __uint_as_float(r[0]) + __uint_as_float(r[1]); }
__device__ __forceinline__ float sum_x32(float s) { auto r = __builtin_amdgcn_permlane32_swap(__float_as_uint(s), __float_as_uint(s), false, false); return __uint_as_float(r[0]) + __uint_as_float(r[1]); }
__device__ __forceinline__ float max_x32(float s) { auto r = __builtin_amdgcn_permlane32_swap(__float_as_uint(s), __float_as_uint(s), false, false); return fmaxf(__uint_as_float(r[0]), __uint_as_float(r[1])); }
__device__ __forceinline__ float shx(float v, int k, int lane) { return __uint_as_float((unsigned)__builtin_amdgcn_ds_bpermute((lane ^ k) << 2, (int)__float_as_uint(v))); }

namespace pg8 {
constexpr int BM = 256, BK = 64, HALF = 128, HTB = HALF * BK * 2, STAGE_BYTES = 8 * HTB, NXCD = 8, WGM = 4;
__host__ __device__ __forceinline__ int lds_byte(int r, int c) { const int st = (r >> 4) * 2 + (c >> 5), rr = r & 15, cc = c & 31, ob = rr * 64 + cc * 2; return st * 1024 + (ob ^ (((ob >> 9) & 1) << 5)); }
__host__ __device__ __forceinline__ void stage_rc(int b, int& R, int& C) { const int st = b / 1024, sb = b % 1024, swz = sb ^ (((sb >> 9) & 1) << 5); R = (st >> 1) * 16 + swz / 64; C = (st & 1) * 32 + (swz % 64) / 2; }
__host__ __device__ __forceinline__ int perm32(int rho) { const int n = rho >> 4, i = rho & 15; return 8 * (i >> 2) + 4 * n + (i & 3); }

struct Unit { int pm, pn; };
constexpr int RS_LDS_OFF = 132096;
template <int NP, int DIM> __device__ __forceinline__ void load_rs8(const float* ssq, const Unit& u, int wr, int fr, int fq, float (&rs)[8]) {
#pragma unroll
    for (int k = 0; k < 8; ++k) { const int row = u.pm * BM + wr * 64 + fr + (k >> 2) * HALF + (k & 3) * 16; float s = 0.f;
#pragma unroll
        for (int q = 0; q < NP / 4; ++q) s += ssq[(size_t)(fq + 4 * q) * MROWS + row];
        s = sum_x16(s); s = sum_x32(s); rs[k] = 1.0f / sqrtf(s * (1.0f / (float)DIM) + RMS_EPS); }
}
template <int N_, int WG = WGM> struct StaticOrder {
    int G, c;
    static constexpr int nM = MROWS / BM, nN = N_ / BM, nwg = nM * nN;
    __device__ __forceinline__ bool next(int i, Unit& u) const {
        const int L = i * G + c; if (L >= nwg) return false;
        int wgid = L; { constexpr int q = nwg / NXCD, r = nwg % NXCD; const int xcd = wgid % NXCD, off = wgid / NXCD; wgid = (xcd < r ? xcd * (q + 1) : r * (q + 1) + (xcd - r) * q) + off; }
        constexpr int nig = WG * nN; const int gid = wgid / nig, fm = gid * WG, gsz = (nM - fm) < WG ? (nM - fm) : WG;
        u.pm = fm + ((wgid % nig) % gsz); u.pn = (wgid % nig) / gsz; return true;
    }
};

template <int NP_IN, int DIM, int ACT, int SSQ_LIM, int SPLIT, int LDC0, int LDC1, bool OUT_FP8 = false> struct EpiB {
    bf16_t* O0; bf16_t* O1; const float* ssq_in; float* ssq_out;
    static constexpr bool HAS_RS = NP_IN > 0;
    __device__ __forceinline__ void load_rs(const Unit& u, int wr, int fr, int fq, float (&rs)[8]) const { if constexpr (NP_IN > 0) load_rs8<NP_IN, DIM>(ssq_in, u, wr, fr, fq, rs); }
    __device__ __forceinline__ void operator()(const f32x4 (&acc)[2][2][4][2], const Unit& u, int wr, int wc, int fr, int fq, const float (&rsv)[8]) const {
        const int rowb = u.pm * BM + wr * 64 + fr;
        int pn = u.pn; bf16_t* O = O0; int ldc = LDC0;
        if (SPLIT < 64 && pn >= SPLIT) { pn -= SPLIT; O = O1; ldc = LDC1; }
        const int col0 = pn * BM + wc * 32 + 8 * fq;
        const bool do_ssq = (SSQ_LIM > 0) && (u.pn < SSQ_LIM);
#pragma unroll
        for (int ai = 0; ai < 2; ++ai)
#pragma unroll
            for (int m = 0; m < 4; ++m) {
                const int row = rowb + ai * HALF + m * 16;
                const float rs = (NP_IN > 0) ? rsv[ai * 4 + m] : 1.f;
                float sq = 0.f;
#pragma unroll
                for (int bj = 0; bj < 2; ++bj) {
                    f32x4 v0 = acc[ai][bj][m][0] * rs, v1 = acc[ai][bj][m][1] * rs;
                    if (ACT) {
#pragma unroll
                        for (int i = 0; i < 4; ++i) { float a = fmaxf(v0[i], 0.f), b = fmaxf(v1[i], 0.f); v0[i] = a * a; v1[i] = b * b; }
                    }
                    if (SSQ_LIM > 0) sq += (v0[0] * v0[0] + v0[1] * v0[1]) + (v0[2] * v0[2] + v0[3] * v0[3]) + (v1[0] * v1[0] + v1[1] * v1[1]) + (v1[2] * v1[2] + v1[3] * v1[3]);
                    if (OUT_FP8) {
                        u32x2 w8; w8.x = pk4_fp8(v0[0] * F8_SCALE_H, v0[1] * F8_SCALE_H, v0[2] * F8_SCALE_H, v0[3] * F8_SCALE_H); w8.y = pk4_fp8(v1[0] * F8_SCALE_H, v1[1] * F8_SCALE_H, v1[2] * F8_SCALE_H, v1[3] * F8_SCALE_H);
                        *(u32x2*)((unsigned char*)O + (size_t)row * ldc + col0 + bj * HALF) = w8;
                    } else {
                    u32x4 w; w.x = cvt_pk_bf16(v0[0], v0[1]); w.y = cvt_pk_bf16(v0[2], v0[3]); w.z = cvt_pk_bf16(v1[0], v1[1]); w.w = cvt_pk_bf16(v1[2], v1[3]);
                    *(u32x4*)(O + (size_t)row * ldc + col0 + bj * HALF) = w;
                    }
                }
                if (do_ssq) {
                    sq = sum_x16(sq); sq = sum_x32(sq);
                    if (fq == 0) ssq_out[(size_t)(u.pn * 4 + wc) * MROWS + row] = sq;
                }
            }
    }
};
struct EpiR {
    const float* base; float* outf; bf16_t* XB; float* ssq_out; float ascale;
    static constexpr bool HAS_RS = false;
    __device__ __forceinline__ void load_rs(const Unit&, int, int, int, float (&)[8]) const {}
    __device__ __forceinline__ void operator()(const f32x4 (&acc)[2][2][4][2], const Unit& u, int wr, int wc, int fr, int fq, const float (&)[8]) const {
        const int rowb = u.pm * BM + wr * 64 + fr;
        const int col0 = u.pn * BM + wc * 32 + 8 * fq;
#pragma unroll
        for (int ai = 0; ai < 2; ++ai) {
            f32x4 pre[4][2][2];
#pragma unroll
            for (int m = 0; m < 4; ++m)
#pragma unroll
                for (int bj = 0; bj < 2; ++bj) { const size_t off = (size_t)(rowb + ai * HALF + m * 16) * DM + col0 + bj * HALF;
                    pre[m][bj][0] = *(const f32x4*)(base + off); pre[m][bj][1] = *(const f32x4*)(base + off + 4); }
#pragma unroll
            for (int m = 0; m < 4; ++m) {
                const int row = rowb + ai * HALF + m * 16;
                float sq = 0.f;
#pragma unroll
                for (int bj = 0; bj < 2; ++bj) {
                    const size_t off = (size_t)row * DM + col0 + bj * HALF;
                    const f32x4 v0 = acc[ai][bj][m][0] * ascale + pre[m][bj][0], v1 = acc[ai][bj][m][1] * ascale + pre[m][bj][1];
                    *(f32x4*)(outf + off) = v0; *(f32x4*)(outf + off + 4) = v1;
                    sq += (v0[0] * v0[0] + v0[1] * v0[1]) + (v0[2] * v0[2] + v0[3] * v0[3]) + (v1[0] * v1[0] + v1[1] * v1[1]) + (v1[2] * v1[2] + v1[3] * v1[3]);
                    u32x4 w; w.x = cvt_pk_bf16(v0[0], v0[1]); w.y = cvt_pk_bf16(v0[2], v0[3]); w.z = cvt_pk_bf16(v1[0], v1[1]); w.w = cvt_pk_bf16(v1[2], v1[3]);
                    *(u32x4*)(XB + off) = w;
                }
                sq = sum_x16(sq); sq = sum_x32(sq);
                if (fq == 0) ssq_out[(size_t)(u.pn * 4 + wc) * MROWS + row] = sq;
            }
            asm volatile("" ::: "memory");
        }
    }
};

struct EpiCU {
    bf16_t* VB; bf16_t* BG; const float* ssq_in;
    static constexpr bool HAS_RS = true;
    __device__ __forceinline__ void load_rs(const Unit& u, int wr, int fr, int fq, float (&rs)[8]) const { load_rs8<32, 2048>(ssq_in, u, wr, fr, fq, rs); }
    __device__ __forceinline__ void operator()(const f32x4 (&acc)[2][2][4][2], const Unit& u, int wr, int wc, int fr, int fq, const float (&rsv)[8]) const {
        const int rowb = u.pm * BM + wr * 64 + fr;
#pragma unroll
        for (int ai = 0; ai < 2; ++ai)
#pragma unroll
            for (int m = 0; m < 4; ++m) {
                const int row = rowb + ai * HALF + m * 16;
                const float rs = rsv[ai * 4 + m];
                if (u.pn < 16) {
                    const f32x4 c0 = acc[ai][0][m][0] * rs, c1 = acc[ai][0][m][1] * rs, u0 = acc[ai][1][m][0] * rs, u1 = acc[ai][1][m][1] * rs;
                    const f32x4 v0 = c0 * u0, v1 = c1 * u1;
                    u32x4 w; w.x = cvt_pk_bf16(v0[0], v0[1]); w.y = cvt_pk_bf16(v0[2], v0[3]); w.z = cvt_pk_bf16(v1[0], v1[1]); w.w = cvt_pk_bf16(v1[2], v1[3]);
                    *(u32x4*)(VB + (size_t)row * DM + u.pn * HALF + wc * 32 + 8 * fq) = w;
                } else {
#pragma unroll
                    for (int bj = 0; bj < 2; ++bj) { const f32x4 v0 = acc[ai][bj][m][0] * rs, v1 = acc[ai][bj][m][1] * rs;
                        u32x4 w; w.x = cvt_pk_bf16(v0[0], v0[1]); w.y = cvt_pk_bf16(v0[2], v0[3]); w.z = cvt_pk_bf16(v1[0], v1[1]); w.w = cvt_pk_bf16(v1[2], v1[3]);
                        *(u32x4*)(BG + (size_t)row * DM + (u.pn - 16) * BM + bj * HALF + wc * 32 + 8 * fq) = w; }
                }
            }
    }
};

struct EpiKV {
    bf16_t* KN; bf16_t* VT; const float* ssq_in;
    static constexpr bool HAS_RS = true;
    __device__ __forceinline__ void load_rs(const Unit& u, int wr, int fr, int fq, float (&rs)[8]) const { load_rs8<8, 512>(ssq_in, u, wr, fr, fq, rs); }
    __device__ __forceinline__ void operator()(const f32x4 (&acc)[2][2][4][2], const Unit& u, int wr, int wc, int fr, int fq, const float (&rsv)[8]) const {
        const int rowb = u.pm * BM + wr * 64 + fr;
#pragma unroll
        for (int ai = 0; ai < 2; ++ai)
#pragma unroll
            for (int m = 0; m < 4; ++m) {
                const int row = rowb + ai * HALF + m * 16;
                const float rs = rsv[ai * 4 + m];
                if (u.pn < 4) {
#pragma unroll
                    for (int bj = 0; bj < 2; ++bj) { const f32x4 v0 = acc[ai][bj][m][0] * rs, v1 = acc[ai][bj][m][1] * rs;
                        u32x4 w; w.x = cvt_pk_bf16(v0[0], v0[1]); w.y = cvt_pk_bf16(v0[2], v0[3]); w.z = cvt_pk_bf16(v1[0], v1[1]); w.w = cvt_pk_bf16(v1[2], v1[3]);
                        *(u32x4*)(KN + (size_t)row * 1024 + u.pn * BM + bj * HALF + wc * 32 + 8 * fq) = w; }
                } else {
                    const int b = row >> 12, sq = row & (SEQ - 1);
#pragma unroll
                    for (int bj = 0; bj < 2; ++bj) { const f32x4 v0 = acc[ai][bj][m][0] * rs, v1 = acc[ai][bj][m][1] * rs;
                        const int h = (u.pn - 4) * 2 + bj, dv0 = wc * 32 + 8 * fq;
                        bf16_t* vp = VT + ((size_t)(b * 8 + h) * 128 + dv0) * SEQ + sq;
                        const unsigned w0 = cvt_pk_bf16(v0[0], v0[1]), w1 = cvt_pk_bf16(v0[2], v0[3]), w2 = cvt_pk_bf16(v1[0], v1[1]), w3 = cvt_pk_bf16(v1[2], v1[3]);
                        vp[0 * SEQ] = (bf16_t)(w0 & 0xffffu); vp[1 * SEQ] = (bf16_t)(w0 >> 16); vp[2 * SEQ] = (bf16_t)(w1 & 0xffffu); vp[3 * SEQ] = (bf16_t)(w1 >> 16);
                        vp[4 * SEQ] = (bf16_t)(w2 & 0xffffu); vp[5 * SEQ] = (bf16_t)(w2 >> 16); vp[6 * SEQ] = (bf16_t)(w3 & 0xffffu); vp[7 * SEQ] = (bf16_t)(w3 >> 16); }
                }
            }
    }
};

template <int N_, int K_, int LDA, int LDB, int APN, bool FP8 = false, int WG = WGM, class EpiT>
__device__ __forceinline__ void gemm_phase(LAS unsigned char* lds, const bf16_t* gA, const bf16_t* gBt, int G, int bid, int wv, const EpiT& E) {
    StaticOrder<N_, WG> S; S.G = G; S.c = bid;
    const int tid = fresh_tid(wv), wid = __builtin_amdgcn_readfirstlane(tid >> 6), lane = tid & 63, wr = wid >> 2, wc = wid & 3, fr = lane & 15, fq = lane >> 4;
    constexpr int nt = K_ / BK;
    unsigned voffA[2], voffB[2];
#pragma unroll
    for (int i = 0; i < 2; ++i) { int R, C; stage_rc(tid * 16 + i * 8192, R, C); const int Rb = (R & ~31) + perm32(R & 31);
        voffA[i] = (unsigned)(R * LDA + C) * 2u; voffB[i] = (unsigned)(Rb * LDB + C) * 2u; }
    constexpr size_t kstep = (size_t)(BK * 2);
    constexpr size_t hstepA = (size_t)HALF * LDA * 2, hstepB = (size_t)HALF * LDB * 2;
    constexpr size_t tstepA = 2 * hstepA, tstepB = 2 * hstepB;
    const unsigned ldsw = (unsigned)wid * 1024u;
    const unsigned ldsbase = (unsigned)__builtin_amdgcn_readfirstlane((int)((unsigned)(uintptr_t)lds + ldsw));
    const int aoff = lds_byte(wr * 64 + fr, fq * 8), boff = lds_byte(wc * 32 + fr, fq * 8);
#define PG8_SA(b, h) (((b) * 2 + (h)) * HTB)
#define PG8_SB(b, h) ((4 + (b) * 2 + (h)) * HTB)
#define PG8_STAGE(bufoff, gbase, voff) do { _Pragma("unroll") for (int _i = 0; _i < 2; ++_i) { \
        if constexpr (true) { unsigned keep_; const char* gb_ = (const char*)(gbase);   \
            asm volatile("s_mov_b32 %0, m0\n\ts_mov_b32 m0, %3\n\ts_nop 0\n\tglobal_load_lds_dwordx4 %1, %2\n\ts_mov_b32 m0, %0" : "=&s"(keep_) : "v"((voff)[_i]), "s"(gb_), "s"(ldsbase + (unsigned)((bufoff) + _i * 8192)) : "memory"); } \
        else __builtin_amdgcn_global_load_lds((const unsigned*)((const char*)(gbase) + (voff)[_i]), (LAS unsigned*)(lds + (bufoff) + ldsw + _i * 8192), 16, 0, 0); } } while (0)
#define PG8_LDA(dst, b, h) do { _Pragma("unroll") for (int m = 0; m < 4; ++m) _Pragma("unroll") for (int k = 0; k < 2; ++k) dst[m][k] = *(const LAS bf16x8*)(lds + PG8_SA(b, h) + aoff + m * 2048 + k * 1024); } while (0)
#define PG8_LDB(dst, b, h) do { _Pragma("unroll") for (int n = 0; n < 2; ++n) _Pragma("unroll") for (int k = 0; k < 2; ++k) dst[n][k] = *(const LAS bf16x8*)(lds + PG8_SB(b, h) + boff + n * 2048 + k * 1024); } while (0)
#define PG8_CAT(x, y) __builtin_shufflevector(__builtin_bit_cast(i32x4, x), __builtin_bit_cast(i32x4, y), 0, 1, 2, 3, 4, 5, 6, 7)
#define PG8_MMA(ai, bj, At, Bt) do { __builtin_amdgcn_s_setprio(1); _Pragma("unroll") for (int m = 0; m < 4; ++m) _Pragma("unroll") for (int n = 0; n < 2; ++n) { \
        if constexpr (FP8) { acc[ai][bj][m][n] = __builtin_amdgcn_mfma_scale_f32_16x16x128_f8f6f4(PG8_CAT(Bt[n][0], Bt[n][1]), PG8_CAT(At[m][0], At[m][1]), acc[ai][bj][m][n], 0, 0, 0, 0, 0, 0); } \
        else { _Pragma("unroll") for (int k = 0; k < 2; ++k) acc[ai][bj][m][n] = __builtin_amdgcn_mfma_f32_16x16x32_bf16(Bt[n][k], At[m][k], acc[ai][bj][m][n], 0, 0, 0); } } \
        __builtin_amdgcn_s_setprio(0); } while (0)
#define PG8_WAIT_V(n) asm volatile("s_waitcnt vmcnt(" #n ")" ::: "memory")
#define PG8_WAIT_L(n) asm volatile("s_waitcnt lgkmcnt(" #n ")" ::: "memory")
#define PG8_BAR __builtin_amdgcn_s_barrier()
#define PG8_SCHED __builtin_amdgcn_sched_barrier(0)
    Unit cur, nxt; int ui = 0;
    if (!S.next(0, cur)) return;
    LAS f32x4* rs_slot = (LAS f32x4*)(lds + RS_LDS_OFF + (wid * 64 + lane) * 32);
    f32x4 acc[2][2][4][2];
#pragma unroll
    for (int a = 0; a < 2; ++a)
#pragma unroll
        for (int b = 0; b < 2; ++b)
#pragma unroll
            for (int m = 0; m < 4; ++m)
#pragma unroll
                for (int n = 0; n < 2; ++n) acc[a][b][m][n] = (f32x4){0.f, 0.f, 0.f, 0.f};
    bf16x8 At[4][2], B0[2][2], B1[2][2];
    const char* cA = (const char*)gA + (size_t)cur.pm * tstepA + (size_t)cur.pn * APN; const char* cB = (const char*)gBt + (size_t)cur.pn * tstepB;
    PG8_STAGE(PG8_SB(0, 0), cB, voffB); PG8_STAGE(PG8_SB(0, 1), cB + hstepB, voffB); PG8_STAGE(PG8_SA(0, 0), cA, voffA); PG8_STAGE(PG8_SA(0, 1), cA + hstepA, voffA);
    if constexpr (EpiT::HAS_RS) { float r0[8]; E.load_rs(cur, wr, fr, fq, r0);
        rs_slot[0] = (f32x4){r0[0], r0[1], r0[2], r0[3]}; rs_slot[1] = (f32x4){r0[4], r0[5], r0[6], r0[7]}; }
    if (wr == 1) PG8_BAR;
    PG8_WAIT_V(2); PG8_BAR;
    PG8_STAGE(PG8_SB(1, 0), cB + kstep, voffB); PG8_STAGE(PG8_SA(1, 0), cA + kstep, voffA); PG8_STAGE(PG8_SB(1, 1), cB + hstepB + kstep, voffB);
    PG8_WAIT_V(6); PG8_BAR;
    for (;;) {
        const bool has_next = S.next(ui + 1, nxt);
        const char* nA = has_next ? (const char*)gA + (size_t)nxt.pm * tstepA + (size_t)nxt.pn * APN : cA; const char* nB = has_next ? (const char*)gBt + (size_t)nxt.pn * tstepB : cB;
        for (int t = 0; t < nt; t += 2) {
            const bool last = (t == nt - 2);
            const char* a1 = cA + (size_t)(t + 1) * kstep;
            const char* a2 = last ? nA : cA + (size_t)(t + 2) * kstep; const char* b2 = last ? nB : cB + (size_t)(t + 2) * kstep;
            const char* a3 = a2 + kstep; const char* b3 = b2 + kstep;
            PG8_LDB(B0, 0, 0); PG8_LDB(B1, 0, 1); PG8_SCHED; PG8_LDA(At, 0, 0); PG8_STAGE(PG8_SA(1, 1), a1 + hstepA, voffA);
            PG8_WAIT_V(8); PG8_WAIT_L(0); PG8_BAR; PG8_MMA(0, 0, At, B0); PG8_MMA(0, 1, At, B1); PG8_BAR; PG8_SCHED;
            PG8_LDA(At, 0, 1); PG8_STAGE(PG8_SB(0, 0), b2, voffB); PG8_STAGE(PG8_SB(0, 1), b2 + hstepB, voffB); PG8_STAGE(PG8_SA(0, 0), a2, voffA);
            PG8_WAIT_V(8); PG8_WAIT_L(0); PG8_BAR; PG8_MMA(1, 0, At, B0); PG8_MMA(1, 1, At, B1); PG8_BAR; PG8_SCHED;
            PG8_LDB(B0, 1, 0); PG8_LDB(B1, 1, 1); PG8_SCHED; PG8_LDA(At, 1, 0); PG8_STAGE(PG8_SA(0, 1), a2 + hstepA, voffA);
            PG8_WAIT_V(8); PG8_WAIT_L(0); PG8_BAR; PG8_MMA(0, 0, At, B0); PG8_MMA(0, 1, At, B1); PG8_BAR; PG8_SCHED;
            PG8_LDA(At, 1, 1); PG8_STAGE(PG8_SB(1, 0), b3, voffB); PG8_STAGE(PG8_SB(1, 1), b3 + hstepB, voffB); PG8_STAGE(PG8_SA(1, 0), a3, voffA);
            PG8_WAIT_V(8); PG8_WAIT_L(0); PG8_BAR; PG8_MMA(1, 0, At, B0); PG8_MMA(1, 1, At, B1); PG8_BAR; PG8_SCHED;
        }
        if (wr == 0) PG8_BAR;
        { const int l2 = fresh_tid(wv) & 63; float rsv[8];
          if constexpr (EpiT::HAS_RS) { const f32x4 a = rs_slot[0], b = rs_slot[1]; rsv[0] = a[0]; rsv[1] = a[1]; rsv[2] = a[2]; rsv[3] = a[3]; rsv[4] = b[0]; rsv[5] = b[1]; rsv[6] = b[2]; rsv[7] = b[3]; }
          E(acc, cur, wr, wc, l2 & 15, l2 >> 4, rsv);
          if constexpr (EpiT::HAS_RS) { if (has_next) { float r1[8]; E.load_rs(nxt, wr, l2 & 15, l2 >> 4, r1);
              rs_slot[0] = (f32x4){r1[0], r1[1], r1[2], r1[3]}; rs_slot[1] = (f32x4){r1[4], r1[5], r1[6], r1[7]}; } } }
        if (!has_next) break;
#pragma unroll
        for (int a = 0; a < 2; ++a)
#pragma unroll
            for (int b = 0; b < 2; ++b)
#pragma unroll
                for (int m = 0; m < 4; ++m)
#pragma unroll
                    for (int n = 0; n < 2; ++n) acc[a][b][m][n] = (f32x4){0.f, 0.f, 0.f, 0.f};
        cur = nxt; cA = nA; cB = nB; ++ui;
        if (wr == 1) PG8_BAR;
    }
    PG8_WAIT_V(0);
    PG8_BAR;
#undef PG8_SA
#undef PG8_SB
#undef PG8_STAGE
#undef PG8_LDA
#undef PG8_LDB
#undef PG8_MMA
#undef PG8_CAT
#undef PG8_WAIT_V
#undef PG8_WAIT_L
#undef PG8_BAR
#undef PG8_SCHED
}
}

struct Args {
    const float* x; const int* pos; const float* mix_g; const float* mlp_g; const float* w_up; const float* w_down;
    const float* e_w_in; const float* e_qa_g; const float* e_kva_g; const float* e_w_uq; const float* e_w_ukv; const float* e_qn_g; const float* e_kn_g;
    const float* e_pool_w; const float* e_pool_s; const float* e_w_out; const float* o_w_in; const float* o_conv_w; const float* o_w_out;
    float* out; unsigned char* ws;
};

__device__ __forceinline__ int maprow(int kind, int n0) {
    if (kind == 1) { return n0 < 1024 ? n0 : (n0 < 1088 ? 2048 + (n0 - 1024) : 1024 + (n0 - 1088)); }
    if (kind == 2) { const int h = n0 / 192, d = n0 % 192; return d < 128 ? h * 128 + d : 1024 + h * 64 + (d - 128); }
    if (kind == 3) { const int h = n0 / 256, d = n0 % 256; return d < 128 ? h * 128 + d : 1024 + h * 128 + (d - 128); }
    if (kind == 4) {
        if (n0 < 2048) return 4096 + n0;
        if (n0 < 4096) { const int ch = n0 - 2048; return 256 * (ch >> 7) + (ch & 127); }
        const int ch = n0 - 4096; return 256 * (ch >> 7) + 128 + (ch & 127); }
    return n0;
}
__device__ __forceinline__ void conv_item(const float* W, int K, int N, const float* gain, const float* nscale, bf16_t* WT, int kind, LAS float* scr, int item, int lane, int f8) {
    const int nblk = N >> 6, kb = item / nblk, nb = item - kb * nblk, k0 = kb * 64, n0 = nb * 64;
    const int r4 = lane >> 4, c4 = (lane & 15) * 4;
    const float* wp = W + (size_t)(k0 + r4) * N + n0 + c4;
    f32x4 v[16];
#pragma unroll
    for (int i = 0; i < 16; ++i) v[i] = *(const f32x4*)(wp + (size_t)(4 * i) * N);
    f32x4 ns = (f32x4){1.f, 1.f, 1.f, 1.f};
    if (nscale) ns = *(const f32x4*)(nscale + n0 + c4);
    float g[16];
#pragma unroll
    for (int i = 0; i < 16; ++i) g[i] = gain ? gain[k0 + 4 * i + r4] : 1.f;
#pragma unroll
    for (int i = 0; i < 16; ++i) { LAS float* sp = scr + (4 * i + r4) * 65 + c4; const f32x4 t = v[i] * ns * g[i]; sp[0] = t.x; sp[1] = t.y; sp[2] = t.z; sp[3] = t.w; }
    asm volatile("s_waitcnt lgkmcnt(0)" ::: "memory");
    const int c = lane & 7, drow0 = maprow(kind, n0);
#pragma unroll
    for (int j = 0; j < 8; ++j) { const int n = (lane >> 3) + 8 * j; const LAS float* s = scr + (8 * c) * 65 + n;
        if (f8) {
            u32x2 o8; o8.x = pk4_fp8(s[0 * 65] * F8_SCALE_W, s[1 * 65] * F8_SCALE_W, s[2 * 65] * F8_SCALE_W, s[3 * 65] * F8_SCALE_W); o8.y = pk4_fp8(s[4 * 65] * F8_SCALE_W, s[5 * 65] * F8_SCALE_W, s[6 * 65] * F8_SCALE_W, s[7 * 65] * F8_SCALE_W);
            *(u32x2*)((unsigned char*)WT + (size_t)(drow0 + n) * K + k0 + 8 * c) = o8;
        } else {
        u32x4 o; o.x = cvt_pk_bf16(s[0 * 65], s[1 * 65]); o.y = cvt_pk_bf16(s[2 * 65], s[3 * 65]); o.z = cvt_pk_bf16(s[4 * 65], s[5 * 65]); o.w = cvt_pk_bf16(s[6 * 65], s[7 * 65]);
        *(u32x4*)(WT + (size_t)(drow0 + n) * K + k0 + 8 * c) = o; } }
    asm volatile("s_waitcnt lgkmcnt(0)" ::: "memory");
}

struct ConvJob { const float* src; const float* gain; const float* nscale; bf16_t* dst; int K, N, kind, items, f8; };
__device__ __forceinline__ ConvJob get_job(int j, const Args& a) {
    ConvJob J; J.gain = nullptr; J.nscale = nullptr; J.kind = 0; J.f8 = 0;
    unsigned char* ws = a.ws;
    if (j < 8) { const int l = j >> 1;
        if ((j & 1) == 0) { J.src = a.w_up + (size_t)l * DM * FF; J.K = DM; J.N = FF; J.gain = a.mlp_g + l * DM; J.dst = (bf16_t*)(ws + W_UP) + (size_t)l * DM * FF; }
        else { J.src = a.w_down + (size_t)l * DM * FF; J.K = FF; J.N = DM; J.dst = (bf16_t*)(ws + W_DOWN) + (size_t)l * DM * FF; J.f8 = (FP8_DOWN_MASK >> l) & 1; }
    } else if (j < 24) { const int e = (j - 8) >> 3, t = (j - 8) & 7;
        if (t == 0) { J.src = a.e_w_in + (size_t)e * DM * 2112; J.K = DM; J.N = 2112; J.gain = a.mix_g + (2 * e) * DM; J.kind = 1; J.dst = (bf16_t*)(ws + W_INE) + (size_t)e * NIN_E * DM; }
        else if (t == 1) { J.src = a.e_w_uq + (size_t)e * 512 * 1536; J.K = 512; J.N = 1536; J.gain = a.e_qa_g + e * 512; J.kind = 2; J.dst = (bf16_t*)(ws + W_UQ) + (size_t)e * 1536 * 512; }
        else if (t == 2) { J.src = a.e_w_ukv + (size_t)e * 512 * 2048; J.K = 512; J.N = 2048; J.gain = a.e_kva_g + e * 512; J.kind = 3; J.dst = (bf16_t*)(ws + W_UKV) + (size_t)e * 2048 * 512; }
        else if (t < 7) { const int gq = t - 3; J.src = a.e_pool_w + (size_t)(e * 4 + gq) * 65536; J.K = 256; J.N = 256; J.nscale = a.e_pool_s + e * 1024 + gq * 256; J.dst = (bf16_t*)(ws + W_POOL) + (size_t)(e * 4 + gq) * 65536; }
        else { J.src = a.e_w_out + (size_t)e * DM * DM; J.K = DM; J.N = DM; J.dst = (bf16_t*)(ws + W_OUTE) + (size_t)e * DM * DM; }
    } else { const int o = (j - 24) >> 1;
        if (((j - 24) & 1) == 0) { J.src = a.o_w_in + (size_t)o * DM * 6144; J.K = DM; J.N = 6144; J.gain = a.mix_g + (2 * o + 1) * DM; J.kind = 4; J.dst = (bf16_t*)(ws + W_INO) + (size_t)o * 6144 * DM; }
        else { J.src = a.o_w_out + (size_t)o * DM * DM; J.K = DM; J.N = DM; J.dst = (bf16_t*)(ws + W_OUTO) + (size_t)o * DM * DM; }
    }
    J.items = (J.K / 64) * (J.N / 64);
    return J;
}

__device__ __forceinline__ void prologue(const Args& a, LAS unsigned char* lds, int gw, int NGW, int lane, int wave) {
    LAS float* scr = (LAS float*)(lds + wave * 16640);
    unsigned char* ws = a.ws;
    constexpr int NITEMS = 4 * (4096 + 4096) + 2 * (1056 + 192 + 256 + 4 * 16 + 1024) + 2 * (3072 + 1024);
    for (int it = gw; it < NITEMS; it += NGW) {
        int r = it, j = 0; ConvJob J = get_job(0, a);
        while (r >= J.items) { r -= J.items; ++j; J = get_job(j, a); }
        conv_item(J.src, J.K, J.N, J.gain, J.nscale, J.dst, J.kind, scr, r, lane, J.f8);
    }
    {
        const int gt = gw * 64 + lane, NGT = NGW * 64;
        for (int e = 0; e < 2; ++e) { u32x4* p = (u32x4*)((bf16_t*)(ws + W_INE) + (size_t)e * NIN_E * DM + (size_t)2112 * DM);
            for (int i = gt; i < 192 * DM / 8; i += NGT) p[i] = (u32x4){0u, 0u, 0u, 0u}; }
        float* rope = (float*)(ws + WS_ROPE);
        for (int i = gt; i < MROWS * 32; i += NGT) { const int m = i >> 5, f = i & 31;
            const float inv = __builtin_amdgcn_exp2f(-(float)f * (13.287712379549449f / 32.0f));
            const float ang = (float)a.pos[m] * inv;
            double rev = (double)ang * 0.15915494309189535; rev -= __builtin_floor(rev);
            const float rf = (float)rev;
            rope[(size_t)m * 64 + f] = __builtin_amdgcn_cosf(rf); rope[(size_t)m * 64 + 32 + f] = __builtin_amdgcn_sinf(rf); }
    }
    bf16_t* XB = (bf16_t*)(ws + WS_XB); float* ssqx = (float*)(ws + WS_SSQX);
    for (int m = gw * 2; m < MROWS; m += NGW * 2) {
        const f32x4* xr = (const f32x4*)(a.x + (size_t)m * DM) + lane;
        f32x4 v[16];
#pragma unroll
        for (int j = 0; j < 16; ++j) v[j] = xr[64 * j];
        u32x2* o8 = (u32x2*)(XB + (size_t)m * DM) + lane;
        float s0 = 0.f, s1 = 0.f;
#pragma unroll
        for (int j = 0; j < 16; ++j) { const float q = (v[j].x * v[j].x + v[j].y * v[j].y) + (v[j].z * v[j].z + v[j].w * v[j].w); if (j < 8) s0 += q; else s1 += q;
            u32x2 w; w.x = cvt_pk_bf16(v[j].x, v[j].y); w.y = cvt_pk_bf16(v[j].z, v[j].w); o8[64 * j] = w; }
#pragma unroll
        for (int o = 1; o < 64; o <<= 1) { s0 += shx(s0, o, lane); s1 += shx(s1, o, lane); }
        if (lane < 32) { ssqx[(size_t)lane * MROWS + m] = (lane == 0) ? s0 : 0.f; ssqx[(size_t)lane * MROWS + m + 1] = (lane == 0) ? s1 : 0.f; }
    }
}

__device__ __forceinline__ void unpack8(const u32x4 v, float* f) { f[0] = bf_lo(v.x); f[1] = bf_hi(v.x); f[2] = bf_lo(v.y); f[3] = bf_hi(v.y); f[4] = bf_lo(v.z); f[5] = bf_hi(v.z); f[6] = bf_lo(v.w); f[7] = bf_hi(v.w); }
__device__ __forceinline__ u32x4 pack8(const float* f) { u32x4 w; w.x = cvt_pk_bf16(f[0], f[1]); w.y = cvt_pk_bf16(f[2], f[3]); w.z = cvt_pk_bf16(f[4], f[5]); w.w = cvt_pk_bf16(f[6], f[7]); return w; }

__device__ __forceinline__ void pool_prep(const bf16_t* CU, bf16_t* PO, int G, int bid, int tid) {
    const int cv = tid & 127, sub = tid >> 7;
    const int grp = cv >> 5, w = 2 << grp;
    for (int c = bid * 4 + sub; c < MROWS / 32; c += G * 4) {
        const int m0 = c * 32, s0 = m0 & (SEQ - 1);
        const bf16_t* up = CU + (size_t)m0 * 2048 + 1024 + cv * 8;
        float sum[8];
#pragma unroll
        for (int i = 0; i < 8; ++i) sum[i] = 0.f;
        if (s0 > 0) for (int k = 1; k < w; ++k) { float f[8]; unpack8(*(const u32x4*)(up - (size_t)k * 2048), f);
#pragma unroll
            for (int i = 0; i < 8; ++i) sum[i] += f[i]; }
#pragma unroll 8
        for (int t = 0; t < 32; ++t) {
            const int s = s0 + t; float f[8], o[8]; unpack8(*(const u32x4*)(up + (size_t)t * 2048), f);
            const float inv = 1.0f / (float)((s + 1) < w ? (s + 1) : w);
#pragma unroll
            for (int i = 0; i < 8; ++i) { sum[i] += f[i]; o[i] = sum[i] * inv - f[i]; }
            *(u32x4*)(PO + (size_t)(m0 + t) * 1024 + cv * 8) = pack8(o);
            if (s - w + 1 >= 0) { float r[8]; unpack8(*(const u32x4*)(up + (long)(t - w + 1) * 2048), r);
#pragma unroll
                for (int i = 0; i < 8; ++i) sum[i] -= r[i]; }
        }
    }
}

__device__ __forceinline__ void conv_phase(const bf16_t* VB, const bf16_t* BG, const float* cw, bf16_t* Gout, int G, int bid, int tid) {
    const int cv = tid & 255, sub = tid >> 8;
    float w0[8], w1[8], w2[8];
#pragma unroll
    for (int i = 0; i < 8; ++i) { w0[i] = cw[cv * 8 + i]; w1[i] = cw[2048 + cv * 8 + i]; w2[i] = cw[4096 + cv * 8 + i]; }
    for (int c = bid * 2 + sub; c < MROWS / 32; c += G * 2) {
        const int m0 = c * 32, s0 = m0 & (SEQ - 1);
        const bf16_t* vp = VB + (size_t)m0 * 2048 + cv * 8; const bf16_t* bp = BG + (size_t)m0 * 2048 + cv * 8;
        float v1[8], v2[8];
#pragma unroll
        for (int i = 0; i < 8; ++i) { v1[i] = 0.f; v2[i] = 0.f; }
        if (s0 > 0) { unpack8(*(const u32x4*)(vp - 2048), v1); unpack8(*(const u32x4*)(vp - 2 * 2048), v2); }
#pragma unroll 8
        for (int t = 0; t < 32; ++t) {
            float bb[8], vv[8], o[8];
            unpack8(*(const u32x4*)(bp + (size_t)t * 2048), bb); unpack8(*(const u32x4*)(vp + (size_t)t * 2048), vv);
#pragma unroll
            for (int i = 0; i < 8; ++i) { const float v = vv[i]; o[i] = bb[i] * (w0[i] * v2[i] + w1[i] * v1[i] + w2[i] * v); v2[i] = v1[i]; v1[i] = v; }
            *(u32x4*)(Gout + (size_t)(m0 + t) * 2048 + cv * 8) = pack8(o);
        }
    }
}

__device__ __forceinline__ void qk_prep(bf16_t* MIX, bf16_t* QROPE, bf16_t* KV, const bf16_t* KR, bf16_t* KROPE, const float* gq, const float* gk, const float* rope, int gw, int NGW, int lane) {
    const int h = lane >> 3, j = lane & 7;
    float gqn[16], gqr[8], gkn[16], gkr[8];
#pragma unroll
    for (int i = 0; i < 16; ++i) { gqn[i] = gq[j * 16 + i]; gkn[i] = gk[j * 16 + i]; }
#pragma unroll
    for (int i = 0; i < 8; ++i) { gqr[i] = gq[128 + j * 8 + i]; gkr[i] = gk[128 + j * 8 + i]; }
#pragma unroll 2
    for (int m = gw; m < MROWS; m += NGW) {
        float cs[8], sn[8];
        { const float* rp = rope + (size_t)m * 64 + 8 * (j & 3);
#pragma unroll
          for (int i = 0; i < 8; ++i) { cs[i] = rp[i]; sn[i] = rp[32 + i]; } }
        const float sgn = (j < 4) ? -1.f : 1.f;
        {
            bf16_t* pn = KV + (size_t)m * 1024 + h * 128 + j * 16; const bf16_t* pr = KR + (size_t)m * 256 + j * 8;
            float a[16], r[8]; unpack8(*(const u32x4*)pn, a); unpack8(*(const u32x4*)(pn + 8), a + 8); unpack8(*(const u32x4*)pr, r);
            float s = 0.f;
#pragma unroll
            for (int i = 0; i < 16; ++i) s += a[i] * a[i];
#pragma unroll
            for (int i = 0; i < 8; ++i) s += r[i] * r[i];
            s += shx(s, 1, lane); s += shx(s, 2, lane); s += shx(s, 4, lane);
            const float rs = 1.0f / sqrtf(s * (1.0f / 192.0f) + RMS_EPS);
#pragma unroll
            for (int i = 0; i < 16; ++i) a[i] = a[i] * rs * gkn[i];
            float o[8];
#pragma unroll
            for (int i = 0; i < 8; ++i) { const float own = r[i] * rs * gkr[i]; const float oth = shx(own, 4, lane); o[i] = own * cs[i] + sgn * oth * sn[i]; }
            *(u32x4*)pn = pack8(a); *(u32x4*)(pn + 8) = pack8(a + 8); *(u32x4*)(KROPE + (size_t)m * 512 + h * 64 + j * 8) = pack8(o);
        }
    }
}

__device__ __forceinline__ void vt_transpose(const bf16_t* KV, bf16_t* VT, LAS unsigned char* lds, int G, int bid, int tid) {
    LAS bf16_t* T0 = (LAS bf16_t*)lds;
    u32x4 v0, v1; int buf = 0;
#define VT_LOAD(it_) do { const int bh_ = (it_) >> 6, tb_ = (it_) & 63, b_ = bh_ >> 3, h_ = bh_ & 7; \
        v0 = *(const u32x4*)(KV + ((size_t)b_ * SEQ + 64 * tb_ + (tid >> 4)) * 2048 + 1024 + h_ * 128 + (tid & 15) * 8); \
        v1 = *(const u32x4*)(KV + ((size_t)b_ * SEQ + 64 * tb_ + 32 + (tid >> 4)) * 2048 + 1024 + h_ * 128 + (tid & 15) * 8); } while (0)
    if (bid < 64 * 64) VT_LOAD(bid);
    for (int it = bid; it < 64 * 64; it += G) {
        LAS bf16_t* T = T0 + buf * (64 * 136);
        *(LAS u32x4*)(T + (tid >> 4) * 136 + (tid & 15) * 8) = v0; *(LAS u32x4*)(T + (32 + (tid >> 4)) * 136 + (tid & 15) * 8) = v1;
        __syncthreads();
        if (it + G < 64 * 64) VT_LOAD(it + G);
        const int bh = it >> 6, tb = it & 63;
#pragma unroll
        for (int k = 0; k < 2; ++k) { const int c = tid + 512 * k, dv = c >> 3, tc = c & 7;
            unsigned short e[8];
#pragma unroll
            for (int i = 0; i < 8; ++i) e[i] = T[(8 * tc + i) * 136 + dv];
            u32x4 w; w.x = e[0] | ((unsigned)e[1] << 16); w.y = e[2] | ((unsigned)e[3] << 16); w.z = e[4] | ((unsigned)e[5] << 16); w.w = e[6] | ((unsigned)e[7] << 16);
            *(u32x4*)(VT + ((size_t)bh * 128 + dv) * SEQ + 64 * tb + 8 * tc) = w; }
        buf ^= 1;
    }
#undef VT_LOAD
    __syncthreads();
}

__device__ __forceinline__ int crow(int r, int hi) { return (r & 3) + 8 * (r >> 2) + 4 * hi; }
constexpr int AT_KROW = 400, AT_VROW = 144, AT_KB = 64 * AT_KROW, AT_VB = 128 * AT_VROW, AT_BUF = AT_KB + AT_VB, AT_WSF = 2 * AT_BUF;

__device__ __forceinline__ void attn_unit(int b, int h, int qb, bf16_t* MIX, const bf16_t* QROPE, const bf16_t* KV, const bf16_t* KROPE, const bf16_t* VT, const float* gq, const float* rope, LAS unsigned char* lds, int wv) {
    const int tid = fresh_tid(wv), lane = tid & 63, w = __builtin_amdgcn_readfirstlane(tid >> 6), r32 = lane & 31, hi = lane >> 5;
    const size_t row0 = (size_t)b * SEQ;
    const int qw = qb * 256 + w * 32;
    bf16x8 qf[12];
    { const bf16_t* qn = MIX + (row0 + qw + r32) * 2048 + h * 128 + hi * 8;
#pragma unroll
      for (int ks = 0; ks < 8; ++ks) qf[ks] = *(const bf16x8*)(qn + 16 * ks);
      const bf16_t* qr = QROPE + (row0 + qw + r32) * 512 + h * 64 + hi * 8;
#pragma unroll
      for (int ks = 0; ks < 4; ++ks) qf[8 + ks] = *(const bf16x8*)(qr + 16 * ks); }
    const int kc0 = tid, kc1 = tid + 512;
    const bf16_t* ksrc0 = KV + (row0 + (kc0 >> 4)) * 1024 + h * 128 + (kc0 & 15) * 8;
    const bf16_t* ksrc1 = KV + (row0 + (kc1 >> 4)) * 1024 + h * 128 + (kc1 & 15) * 8;
    const bf16_t* ksrc2 = KROPE + (row0 + (tid >> 3)) * 512 + h * 64 + (tid & 7) * 8;
    const bf16_t* vsrc0 = VT + ((size_t)(b * 8 + h) * 128 + (kc0 >> 3)) * SEQ + (kc0 & 7) * 8;
    const bf16_t* vsrc1 = VT + ((size_t)(b * 8 + h) * 128 + (kc1 >> 3)) * SEQ + (kc1 & 7) * 8;
    const int kd0 = (kc0 >> 4) * AT_KROW + (kc0 & 15) * 16, kd1 = (kc1 >> 4) * AT_KROW + (kc1 & 15) * 16, kd2 = (tid >> 3) * AT_KROW + 256 + (tid & 7) * 16;
    const int vd0 = AT_KB + (kc0 >> 3) * AT_VROW + (kc0 & 7) * 16, vd1 = AT_KB + (kc1 >> 3) * AT_VROW + (kc1 & 7) * 16;
    u32x4 s0, s1, s2, s3, s4;
#define AT_GLOAD(t) do { s0 = *(const u32x4*)(ksrc0 + (size_t)(t) * 64 * 1024); s1 = *(const u32x4*)(ksrc1 + (size_t)(t) * 64 * 1024); s2 = *(const u32x4*)(ksrc2 + (size_t)(t) * 64 * 512); \
        s3 = *(const u32x4*)(vsrc0 + (t) * 64); s4 = *(const u32x4*)(vsrc1 + (t) * 64); } while (0)
#define AT_LSTORE(buf) do { LAS unsigned char* bb = lds + (buf) * AT_BUF; *(LAS u32x4*)(bb + kd0) = s0; *(LAS u32x4*)(bb + kd1) = s1; *(LAS u32x4*)(bb + kd2) = s2; *(LAS u32x4*)(bb + vd0) = s3; *(LAS u32x4*)(bb + vd1) = s4; } while (0)
    AT_GLOAD(0);
    __builtin_amdgcn_sched_barrier(0);
    {
        f32x4 gn[8][2], gr1[2][2], gr2[2][2], csv[2][2], snv[2][2];
        const float* rp = rope + (row0 + qw + r32) * 64;
#pragma unroll
        for (int ks = 0; ks < 8; ++ks) { gn[ks][0] = *(const f32x4*)(gq + 16 * ks + 8 * hi); gn[ks][1] = *(const f32x4*)(gq + 16 * ks + 8 * hi + 4); }
        __builtin_amdgcn_sched_barrier(0);
        float ssq = 0.f;
#pragma unroll
        for (int ks = 0; ks < 12; ++ks) { float f[8]; unpack8(__builtin_bit_cast(u32x4, qf[ks]), f);
#pragma unroll
            for (int e = 0; e < 8; ++e) ssq += f[e] * f[e]; }
        ssq = sum_x32(ssq);
        const float rs = (1.0f / sqrtf(ssq * (1.0f / 192.0f) + RMS_EPS)) * QSCALE;
#pragma unroll
        for (int ks = 0; ks < 8; ++ks) { float f[8]; unpack8(__builtin_bit_cast(u32x4, qf[ks]), f);
#pragma unroll
            for (int e = 0; e < 8; ++e) f[e] = f[e] * rs * gn[ks][e >> 2][e & 3];
            qf[ks] = __builtin_bit_cast(bf16x8, pack8(f)); }
        __builtin_amdgcn_sched_barrier(0);
#pragma unroll
        for (int j = 0; j < 2; ++j) { const int i0 = 16 * j + 8 * hi;
            gr1[j][0] = *(const f32x4*)(gq + 128 + i0); gr1[j][1] = *(const f32x4*)(gq + 128 + i0 + 4); gr2[j][0] = *(const f32x4*)(gq + 160 + i0); gr2[j][1] = *(const f32x4*)(gq + 160 + i0 + 4);
            csv[j][0] = *(const f32x4*)(rp + i0); csv[j][1] = *(const f32x4*)(rp + i0 + 4); snv[j][0] = *(const f32x4*)(rp + 32 + i0); snv[j][1] = *(const f32x4*)(rp + 32 + i0 + 4); }
        __builtin_amdgcn_sched_barrier(0);
#pragma unroll
        for (int j = 0; j < 2; ++j) { float x1[8], x2[8], o1[8], o2[8];
            unpack8(__builtin_bit_cast(u32x4, qf[8 + j]), x1); unpack8(__builtin_bit_cast(u32x4, qf[10 + j]), x2);
#pragma unroll
            for (int e = 0; e < 8; ++e) { const float a1 = x1[e] * rs * gr1[j][e >> 2][e & 3], a2 = x2[e] * rs * gr2[j][e >> 2][e & 3], cs = csv[j][e >> 2][e & 3], sn = snv[j][e >> 2][e & 3];
                o1[e] = a1 * cs - a2 * sn; o2[e] = a2 * cs + a1 * sn; }
            qf[8 + j] = __builtin_bit_cast(bf16x8, pack8(o1)); qf[10 + j] = __builtin_bit_cast(bf16x8, pack8(o2)); }
    }
    f32x16 o[4];
#pragma unroll
    for (int d = 0; d < 4; ++d)
#pragma unroll
        for (int r = 0; r < 16; ++r) o[d][r] = 0.f;
    float mref = 0.f, lrun = 0.f;
    f32x16 negm;
#pragma unroll
    for (int r = 0; r < 16; ++r) negm[r] = 0.f;
    const int NT = 4 * (qb + 1);
    AT_LSTORE(0);
    const int pi = 16 * (r32 >> 4) + 8 * ((r32 >> 2) & 1) + 4 * ((r32 >> 3) & 1) + (r32 & 3);
    LAS float* wsf = (LAS float*)(lds + AT_WSF) + w * 32;
    const int qabs = qw + r32;
    for (int t = 0; t < NT; ++t) {
        __syncthreads();
        if (t + 1 < NT) AT_GLOAD(t + 1);
        if (64 * t <= qw + 31) {
            const LAS unsigned char* kb = lds + (t & 1) * AT_BUF + pi * AT_KROW + hi * 16;
            const LAS unsigned char* vb = lds + (t & 1) * AT_BUF + AT_KB + r32 * AT_VROW + hi * 16;
            __builtin_amdgcn_sched_barrier(0);
            f32x16 p0, p1;
#pragma unroll
            for (int ks = 0; ks < 12; ++ks) {
                const bf16x8 k0 = *(const LAS bf16x8*)(kb + ks * 32);
                const bf16x8 k1 = *(const LAS bf16x8*)(kb + 32 * AT_KROW + ks * 32);
                p0 = __builtin_amdgcn_mfma_f32_32x32x16_bf16(k0, qf[ks], ks == 0 ? negm : p0, 0, 0, 0);
                p1 = __builtin_amdgcn_mfma_f32_32x32x16_bf16(k1, qf[ks], ks == 0 ? negm : p1, 0, 0, 0);
            }
            __builtin_amdgcn_sched_group_barrier(0x100, 12, 0);
#pragma unroll
            for (int i = 0; i < 6; ++i) { __builtin_amdgcn_sched_group_barrier(0x008, 2, 0); __builtin_amdgcn_sched_group_barrier(0x100, 2, 0); }
            __builtin_amdgcn_sched_group_barrier(0x008, 12, 0);
            __builtin_amdgcn_sched_barrier(0);
            if (64 * t + 63 > qw) {
#pragma unroll
                for (int r = 0; r < 16; ++r) { const int key = 64 * t + 16 * (r >> 3) + 8 * hi + (r & 7);
                    if (key > qabs) p0[r] = -INFINITY; if (key + 32 > qabs) p1[r] = -INFINITY; }
            }
            float rm = fmaxf(p0[0], p1[0]);
#pragma unroll
            for (int r = 1; r < 16; ++r) rm = fmaxf(rm, fmaxf(p0[r], p1[r]));
            rm = max_x32(rm);
            if (t == 0 || __any(rm > 8.0f)) {
                const float dl = (t == 0) ? rm : fmaxf(rm, 0.f);
                mref += dl;
#pragma unroll
                for (int r = 0; r < 16; ++r) { p0[r] -= dl; p1[r] -= dl; negm[r] = -mref; }
                const float alpha = __builtin_amdgcn_exp2f(-dl);
                lrun *= alpha;
                if (t > 0) {
                    if (hi == 0) wsf[r32] = alpha;
                    asm volatile("s_waitcnt lgkmcnt(0)" ::: "memory");
                    float al[16];
#pragma unroll
                    for (int r = 0; r < 16; ++r) al[r] = wsf[crow(r, hi)];
#pragma unroll
                    for (int d = 0; d < 4; ++d)
#pragma unroll
                        for (int r = 0; r < 16; ++r) o[d][r] *= al[r];
                    asm volatile("s_waitcnt lgkmcnt(0)" ::: "memory");
                }
            }
            {
                typedef float f32x2 __attribute__((ext_vector_type(2)));
                f32x2 rs2 = (f32x2){0.f, 0.f};
#pragma unroll
                for (int r = 0; r < 16; r += 2) {
                    p0[r] = __builtin_amdgcn_exp2f(p0[r]); p0[r + 1] = __builtin_amdgcn_exp2f(p0[r + 1]); p1[r] = __builtin_amdgcn_exp2f(p1[r]); p1[r + 1] = __builtin_amdgcn_exp2f(p1[r + 1]);
                    rs2 += (f32x2){p0[r], p0[r + 1]}; rs2 += (f32x2){p1[r], p1[r + 1]};
                }
                lrun += rs2.x + rs2.y;
            }
            bf16x8 pa[4];
            { u32x4 t0, t1, t2, t3;
              t0.x = cvt_pk_bf16(p0[0], p0[1]); t0.y = cvt_pk_bf16(p0[2], p0[3]); t0.z = cvt_pk_bf16(p0[4], p0[5]); t0.w = cvt_pk_bf16(p0[6], p0[7]);
              t1.x = cvt_pk_bf16(p0[8], p0[9]); t1.y = cvt_pk_bf16(p0[10], p0[11]); t1.z = cvt_pk_bf16(p0[12], p0[13]); t1.w = cvt_pk_bf16(p0[14], p0[15]);
              t2.x = cvt_pk_bf16(p1[0], p1[1]); t2.y = cvt_pk_bf16(p1[2], p1[3]); t2.z = cvt_pk_bf16(p1[4], p1[5]); t2.w = cvt_pk_bf16(p1[6], p1[7]);
              t3.x = cvt_pk_bf16(p1[8], p1[9]); t3.y = cvt_pk_bf16(p1[10], p1[11]); t3.z = cvt_pk_bf16(p1[12], p1[13]); t3.w = cvt_pk_bf16(p1[14], p1[15]);
              pa[0] = __builtin_bit_cast(bf16x8, t0); pa[1] = __builtin_bit_cast(bf16x8, t1); pa[2] = __builtin_bit_cast(bf16x8, t2); pa[3] = __builtin_bit_cast(bf16x8, t3); }
            __builtin_amdgcn_sched_barrier(0);
#pragma unroll
            for (int j = 0; j < 4; ++j)
#pragma unroll
                for (int d = 0; d < 4; ++d) {
                    const bf16x8 vf = *(const LAS bf16x8*)(vb + d * 32 * AT_VROW + j * 32);
                    o[d] = __builtin_amdgcn_mfma_f32_32x32x16_bf16(pa[j], vf, o[d], 0, 0, 0);
                }
            __builtin_amdgcn_sched_group_barrier(0x100, 8, 0);
#pragma unroll
            for (int i = 0; i < 4; ++i) { __builtin_amdgcn_sched_group_barrier(0x008, 2, 0); __builtin_amdgcn_sched_group_barrier(0x100, 2, 0); }
            __builtin_amdgcn_sched_group_barrier(0x008, 8, 0);
            __builtin_amdgcn_sched_barrier(0);
        }
        if (t + 1 < NT) AT_LSTORE((t + 1) & 1);
    }
#undef AT_GLOAD
#undef AT_LSTORE
    lrun = sum_x32(lrun);
    if (hi == 0) wsf[r32] = 1.0f / lrun;
    asm volatile("s_waitcnt lgkmcnt(0)" ::: "memory");
    float rl[16];
#pragma unroll
    for (int r = 0; r < 16; ++r) rl[r] = wsf[crow(r, hi)];
    asm volatile("s_waitcnt lgkmcnt(0)" ::: "memory");
#pragma unroll
    for (int r = 0; r < 16; ++r) {
        bf16_t* op = MIX + (row0 + qw + crow(r, hi)) * 2048 + h * 128 + r32;
#pragma unroll
        for (int d = 0; d < 4; ++d) op[d * 32] = (bf16_t)(cvt_pk_bf16(o[d][r] * rl[r], 0.f) & 0xffffu);
    }
    __syncthreads();
}

__device__ __forceinline__ void attn_phase(bf16_t* MIX, const bf16_t* QROPE, const bf16_t* KV, const bf16_t* KROPE, const bf16_t* VT, const float* gq, const float* rope, LAS unsigned char* lds, int G, int bid, int wv) {
    for (int r = 0;; ++r) {
        const int idx = r * G + ((r & 1) ? (G - 1 - bid) : bid);
        if (r * G >= 1024) break;
        if (idx >= 1024) continue;
        const int qb = 15 - (idx >> 6), bh = idx & 63;
        attn_unit(bh >> 3, bh & 7, qb, MIX, QROPE, KV, KROPE, VT, gq, rope, lds, wv);
    }
}

#define XB_TMO      128
#define XB_XCNT(j)  (256  + 64 * (j))
#define XB_XSUB(j)  (1280 + 64 * (j))
#define XB_XGEN(j)  (2304 + 64 * (j))
#define XB_TOP      3328
#define XB_TOPGEN   3392
#define XCD_BAR_WORDS 3456
#define XB_SPIN_CAP (1u << 18)
constexpr int MISC_OFF = 131072 + 320;
__device__ __forceinline__ unsigned xb_ld(unsigned* p)              { return __hip_atomic_load(p, __ATOMIC_RELAXED, __HIP_MEMORY_SCOPE_AGENT); }
__device__ __forceinline__ unsigned xb_add(unsigned* p, unsigned v) { return __hip_atomic_fetch_add(p, v, __ATOMIC_RELAXED, __HIP_MEMORY_SCOPE_AGENT); }
__device__ __forceinline__ unsigned xb_xcc_id() { return (unsigned)__builtin_amdgcn_s_getreg((3 << 11) | 20) & 0xFu; }
#define XB_SPIN(cond, bar) do { unsigned _sp = 0; while (cond) { __builtin_amdgcn_s_sleep(1); \
    if ((++_sp & 255u) == 0u) { if (xb_ld(&(bar)[XB_TMO])) break; if (_sp > XB_SPIN_CAP) { atomicAdd(&(bar)[XB_TMO], 1u); break; } } } } while (0)
__device__ __forceinline__ void xcd_barrier_complete(unsigned* bar, unsigned x, unsigned G, unsigned& nloc, unsigned& nx) {
    unsigned sum, cnt, mine, sp = 0u;
    for (;;) {
        sum = 0u; cnt = 0u; mine = 0u;
#pragma unroll
        for (unsigned j = 0; j < 16; ++j) { const unsigned c = xb_ld(&bar[XB_XCNT(j)]); sum += c; cnt += (c > 0u) ? 1u : 0u; mine = (j == x) ? c : mine; }
        if (sum == G) break;
        __builtin_amdgcn_s_sleep(1);
        if ((++sp & 255u) == 0u) { if (xb_ld(&bar[XB_TMO])) break; if (sp > XB_SPIN_CAP) { atomicAdd(&bar[XB_TMO], 1u); break; } }
    }
    nloc = mine > 0u ? mine : 1u; nx = cnt > 0u ? cnt : 1u;
}
__device__ __forceinline__ void xcd_barrier(unsigned* bar, volatile LAS unsigned* st, bool t0, unsigned G) {
    asm volatile("s_waitcnt vmcnt(0)" ::: "memory");
    __syncthreads();
    if (t0) {
        const unsigned x = xb_xcc_id();
        __builtin_amdgcn_s_waitcnt(0);
        unsigned nloc = st[0], nx = st[1];
        if (nloc == 0u) { xcd_barrier_complete(bar, x, G, nloc, nx); st[0] = nloc; st[1] = nx; }
        const unsigned old = xb_add(&bar[XB_XSUB(x)], 1u);
        const unsigned gen = old / nloc;
        if (old + 1u == (gen + 1u) * nloc) {
            __builtin_amdgcn_fence(__ATOMIC_RELEASE, "agent");
            asm volatile("s_waitcnt vmcnt(0)" ::: "memory");
            const unsigned og = xb_add(&bar[XB_TOP], 1u);
            const unsigned tg = og / nx;
            if (og + 1u == (tg + 1u) * nx) xb_add(&bar[XB_TOPGEN], 1u);
            else XB_SPIN(xb_ld(&bar[XB_TOPGEN]) == tg, bar);
            __builtin_amdgcn_fence(__ATOMIC_ACQUIRE, "agent");
            xb_add(&bar[XB_XGEN(x)], 1u);
            asm volatile("s_waitcnt vmcnt(0)" ::: "memory");
        } else {
            XB_SPIN(xb_ld(&bar[XB_XGEN(x)]) == gen, bar);
            __builtin_amdgcn_fence(__ATOMIC_ACQUIRE, "agent");
            asm volatile("s_waitcnt vmcnt(0)" ::: "memory");
        }
    }
    __syncthreads();
}

typedef const __attribute__((address_space(4))) Args* KArgsP;
__device__ __forceinline__ KArgsP kargs() { KArgsP p = (KArgsP)__builtin_amdgcn_kernarg_segment_ptr(); asm volatile("" : "+s"(p)); return p; }
#define PH_SETUP() asm volatile("" : "+s"(G), "+s"(bid)); const KArgsP ka = kargs(); unsigned char* const ws = ka->ws; const int tid = fresh_tid(wv); const int lane = tid & 63, wave = wv; (void)lane; (void)wave
#define WSP(T, off) ((T*)(ws + (off)))

__device__ __forceinline__ void ph_prologue(LAS unsigned char* lds, int G, int bid, int wv) {
    PH_SETUP();
    Args a;
    a.x = ka->x; a.pos = ka->pos; a.mix_g = ka->mix_g; a.mlp_g = ka->mlp_g; a.w_up = ka->w_up; a.w_down = ka->w_down; a.e_w_in = ka->e_w_in; a.e_qa_g = ka->e_qa_g; a.e_kva_g = ka->e_kva_g;
    a.e_w_uq = ka->e_w_uq; a.e_w_ukv = ka->e_w_ukv; a.e_qn_g = ka->e_qn_g; a.e_kn_g = ka->e_kn_g; a.e_pool_w = ka->e_pool_w; a.e_pool_s = ka->e_pool_s; a.e_w_out = ka->e_w_out;
    a.o_w_in = ka->o_w_in; a.o_conv_w = ka->o_conv_w; a.o_w_out = ka->o_w_out; a.out = ka->out; a.ws = ws;
    prologue(a, lds, bid * 8 + wave, G * 8, lane, wave);
}
__device__ __forceinline__ void ph_e1(LAS unsigned char* lds, int e, int G, int bid, int wv) {
    asm volatile("" : "+s"(e));
    PH_SETUP();
    pg8::EpiB<32, 2048, 0, 4, 8, 2048, 256> E{WSP(bf16_t, H_CU), WSP(bf16_t, H_KR), WSP(float, WS_SSQX), WSP(float, WS_SSQC)};
    pg8::gemm_phase<NIN_E, 2048, 2048, 2048, 0>(lds, WSP(bf16_t, WS_XB), WSP(bf16_t, W_INE) + (size_t)e * NIN_E * DM, G, bid, wv, E);
}
__device__ __forceinline__ void ph_e2a(int G, int bid, int wv) { PH_SETUP(); pool_prep(WSP(bf16_t, H_CU), WSP(bf16_t, H_POOLED), G, bid, tid); }
__device__ __forceinline__ void ph_e2b(LAS unsigned char* lds, int e, int G, int bid, int wv) {
    asm volatile("" : "+s"(e));
    PH_SETUP();
    pg8::EpiB<8, 512, 0, 0, 4, 2048, 512> E{WSP(bf16_t, H_MIX), WSP(bf16_t, H_QROPE), WSP(float, WS_SSQC), nullptr};
    pg8::gemm_phase<1536, 512, 2048, 512, 0>(lds, WSP(bf16_t, H_CU), WSP(bf16_t, W_UQ) + (size_t)e * 1536 * 512, G, bid, wv, E);
}
__device__ __forceinline__ void ph_e2c(LAS unsigned char* lds, int e, int G, int bid, int wv) {
    asm volatile("" : "+s"(e));
    PH_SETUP();
    pg8::EpiKV E{WSP(bf16_t, H_KV), WSP(bf16_t, H_VT), WSP(float, WS_SSQC) + (size_t)8 * MROWS};
    pg8::gemm_phase<2048, 512, 2048, 512, 0>(lds, WSP(bf16_t, H_CU) + 512, WSP(bf16_t, W_UKV) + (size_t)e * 2048 * 512, G, bid, wv, E);
}
__device__ __forceinline__ void ph_e3a(LAS unsigned char* lds, int e, int G, int bid, int wv) {
    asm volatile("" : "+s"(e));
    PH_SETUP();
    pg8::EpiB<0, 1, 0, 0, 99, 2048, 0> E{WSP(bf16_t, H_MIX) + 1024, nullptr, nullptr, nullptr};
    pg8::gemm_phase<1024, 256, 1024, 256, 512>(lds, WSP(bf16_t, H_POOLED), WSP(bf16_t, W_POOL) + (size_t)e * 4 * 65536, G, bid, wv, E);
}
__device__ __forceinline__ void ph_e3b(int e, int G, int bid, int wv) {
    asm volatile("" : "+s"(e));
    PH_SETUP();
    qk_prep(WSP(bf16_t, H_MIX), WSP(bf16_t, H_QROPE), WSP(bf16_t, H_KV), WSP(bf16_t, H_KR), WSP(bf16_t, H_KROPE), ka->e_qn_g + e * 192, ka->e_kn_g + e * 192, WSP(float, WS_ROPE), bid * 8 + wave, G * 8, lane);
}
__device__ __forceinline__ void ph_e3c(LAS unsigned char* lds, int G, int bid, int wv) { PH_SETUP(); vt_transpose(WSP(bf16_t, H_KV), WSP(bf16_t, H_VT), lds, G, bid, tid); }
__device__ __forceinline__ void ph_e4(LAS unsigned char* lds, int e, int G, int bid, int wv) {
    asm volatile("" : "+s"(e));
    PH_SETUP();
    attn_phase(WSP(bf16_t, H_MIX), WSP(bf16_t, H_QROPE), WSP(bf16_t, H_KV), WSP(bf16_t, H_KROPE), WSP(bf16_t, H_VT), ka->e_qn_g + e * 192, WSP(float, WS_ROPE), lds, G, bid, wv);
}
__device__ __forceinline__ void ph_o1(LAS unsigned char* lds, int o, int G, int bid, int wv) {
    asm volatile("" : "+s"(o));
    PH_SETUP();
    pg8::EpiCU E{WSP(bf16_t, H_VB), WSP(bf16_t, H_BG), WSP(float, WS_SSQX)};
    pg8::gemm_phase<6144, 2048, 2048, 2048, 0, false, 4>(lds, WSP(bf16_t, WS_XB), WSP(bf16_t, W_INO) + (size_t)o * 6144 * DM, G, bid, wv, E);
}
__device__ __forceinline__ void ph_o2(int o, int G, int bid, int wv) {
    asm volatile("" : "+s"(o));
    PH_SETUP(); conv_phase(WSP(bf16_t, H_VB), WSP(bf16_t, H_BG), ka->o_conv_w + (size_t)o * 3 * DM, WSP(bf16_t, H_G), G, bid, tid); }
__device__ __forceinline__ void ph_mixout(LAS unsigned char* lds, int l, int G, int bid, int wv) {
    asm volatile("" : "+s"(l));
    PH_SETUP();
    const int e = l >> 1;
    const bf16_t* A = (l & 1) ? WSP(bf16_t, H_G) : WSP(bf16_t, H_MIX);
    const bf16_t* B = ((l & 1) ? WSP(bf16_t, W_OUTO) : WSP(bf16_t, W_OUTE)) + (size_t)e * DM * DM;
    float* out = ka->out;
    pg8::EpiR E{(l == 0) ? ka->x : (const float*)out, out, WSP(bf16_t, WS_XB), WSP(float, WS_SSQX), 1.0f};
    pg8::gemm_phase<2048, 2048, 2048, 2048, 0, false, 4>(lds, A, B, G, bid, wv, E);
}
__device__ __forceinline__ void ph_up(LAS unsigned char* lds, int l, int G, int bid, int wv) {
    asm volatile("" : "+s"(l));
    PH_SETUP();
    pg8::EpiB<32, 2048, 1, 0, 99, 8192, 0> E{WSP(bf16_t, WS_H), nullptr, WSP(float, WS_SSQX), nullptr};
    pg8::gemm_phase<8192, 2048, 2048, 2048, 0, false, 4>(lds, WSP(bf16_t, WS_XB), WSP(bf16_t, W_UP) + (size_t)l * DM * FF, G, bid, wv, E);
}
__device__ __forceinline__ void ph_down(LAS unsigned char* lds, int l, int G, int bid, int wv) {
    asm volatile("" : "+s"(l));
    PH_SETUP();
    float* out = ka->out;
    pg8::EpiR E{out, out, WSP(bf16_t, WS_XB), WSP(float, WS_SSQX), 1.0f};
    pg8::gemm_phase<2048, 8192, 8192, 8192, 0, false, 4>(lds, WSP(bf16_t, WS_H), WSP(bf16_t, W_DOWN) + (size_t)l * DM * FF, G, bid, wv, E);
}
__device__ __forceinline__ void ph_up_f8(LAS unsigned char* lds, int l, int G, int bid, int wv) {
    asm volatile("" : "+s"(l));
    PH_SETUP();
    pg8::EpiB<32, 2048, 1, 0, 99, 8192, 0, true> E{WSP(bf16_t, WS_H), nullptr, WSP(float, WS_SSQX), nullptr};
    pg8::gemm_phase<8192, 2048, 2048, 2048, 0, false, 4>(lds, WSP(bf16_t, WS_XB), WSP(bf16_t, W_UP) + (size_t)l * DM * FF, G, bid, wv, E);
}
__device__ __forceinline__ void ph_down_f8(LAS unsigned char* lds, int l, int G, int bid, int wv) {
    asm volatile("" : "+s"(l));
    PH_SETUP();
    float* out = ka->out;
    pg8::EpiR E{out, out, WSP(bf16_t, WS_XB), WSP(float, WS_SSQX), F8_UNSCALE};
    pg8::gemm_phase<2048, 4096, 4096, 4096, 0, true>(lds, WSP(bf16_t, WS_H), WSP(bf16_t, W_DOWN) + (size_t)l * DM * FF, G, bid, wv, E);
}

__global__ void __launch_bounds__(512, 2) mk_fwd(Args a_) {
    extern __shared__ __attribute__((aligned(16))) unsigned char lds_raw[];
    LAS unsigned char* lds = (LAS unsigned char*)lds_raw;
    cg::grid_group grid = cg::this_grid();
    const int G = gridDim.x, bid = blockIdx.x, wv = __builtin_amdgcn_readfirstlane((int)threadIdx.x >> 6);
    if (bid == 0) {
        unsigned* bar0 = (unsigned*)kargs()->ws;
        for (int i = fresh_tid(wv); i < XCD_BAR_WORDS; i += 512) bar0[i] = 0u;
    }
    ph_prologue(lds, G, bid, wv);
    grid.sync();
    { const bool t0 = fresh_tid(wv) == 0;
      volatile LAS unsigned* st = (volatile LAS unsigned*)(lds + MISC_OFF);
      if (t0) { st[0] = 0u; st[1] = 0u; (void)xb_add(&((unsigned*)kargs()->ws)[XB_XCNT(xb_xcc_id())], 1u); }
      __syncthreads(); }
#define GSYNC() xcd_barrier((unsigned*)kargs()->ws, (volatile LAS unsigned*)(lds + MISC_OFF), fresh_tid(wv) == 0, (unsigned)G)
    for (int l = 0; l < 4; ++l) {
        const int e = l >> 1;
        if ((l & 1) == 0) {
            ph_e1(lds, e, G, bid, wv); GSYNC();
            ph_e2a(G, bid, wv); ph_e2b(lds, e, G, bid, wv); ph_e2c(lds, e, G, bid, wv); GSYNC();
            ph_e3a(lds, e, G, bid, wv); ph_e3b(e, G, bid, wv); GSYNC();
            ph_e4(lds, e, G, bid, wv); GSYNC();
        } else {
            ph_o1(lds, e, G, bid, wv); GSYNC();
            ph_o2(e, G, bid, wv); GSYNC();
        }
        ph_mixout(lds, l, G, bid, wv); GSYNC();
        if ((FP8_DOWN_MASK >> l) & 1) {
            ph_up_f8(lds, l, G, bid, wv); GSYNC();
            ph_down_f8(lds, l, G, bid, wv);
        } else {
            if (FP8_DOWN_MASK != 15) { ph_up(lds, l, G, bid, wv); GSYNC(); ph_down(lds, l, G, bid, wv); }
        }
        if (l < 3) GSYNC();
    }
}

extern "C" void kernel_launch(void* const* d_in, const int* in_sizes, int n_in, void* d_out, int out_size, void* d_ws, size_t ws_size, hipStream_t stream) {
    static int grid = 0;
    if (grid == 0) {
        if (n_in != 19 || ws_size < WS_END) { fprintf(stderr, "kernel_launch: unexpected n_in %d / ws_size %zu\n", n_in, ws_size); grid = -1; return; }
        int dev = 0, cus = 0, per_cu = 0;
        hipGetDevice(&dev);
        hipDeviceGetAttribute(&cus, hipDeviceAttributeMultiprocessorCount, dev);
        if (hipFuncSetAttribute((const void*)mk_fwd, hipFuncAttributeMaxDynamicSharedMemorySize, LDS_BYTES) != hipSuccess) { fprintf(stderr, "kernel_launch: hipFuncSetAttribute failed\n"); grid = -1; return; }
        if (hipOccupancyMaxActiveBlocksPerMultiprocessor(&per_cu, (const void*)mk_fwd, 512, LDS_BYTES) != hipSuccess || per_cu < 1) { fprintf(stderr, "kernel_launch: occupancy query gave %d\n", per_cu); per_cu = 1; }
        (void)hipGetLastError();
        grid = cus * 1;
        (void)per_cu;
    }
    if (grid < 0) return;
    Args a{};
    a.x = (const float*)d_in[0]; a.pos = (const int*)d_in[1]; a.mix_g = (const float*)d_in[2]; a.mlp_g = (const float*)d_in[3]; a.w_up = (const float*)d_in[4]; a.w_down = (const float*)d_in[5];
    a.e_w_in = (const float*)d_in[6]; a.e_qa_g = (const float*)d_in[7]; a.e_kva_g = (const float*)d_in[8]; a.e_w_uq = (const float*)d_in[9]; a.e_w_ukv = (const float*)d_in[10];
    a.e_qn_g = (const float*)d_in[11]; a.e_kn_g = (const float*)d_in[12]; a.e_pool_w = (const float*)d_in[13]; a.e_pool_s = (const float*)d_in[14]; a.e_w_out = (const float*)d_in[15];
    a.o_w_in = (const float*)d_in[16]; a.o_conv_w = (const float*)d_in[17]; a.o_w_out = (const float*)d_in[18];
    a.out = (float*)d_out; a.ws = (unsigned char*)d_ws;
    void* args[] = {&a};
    hipError_t e = hipLaunchCooperativeKernel((const void*)mk_fwd, dim3(grid), dim3(512), args, LDS_BYTES, stream);
    if (e != hipSuccess) fprintf(stderr, "kernel_launch: cooperative launch failed: %s (grid %d)\n", hipGetErrorString(e), grid);
}
```

```cpp
#include <hip/hip_runtime.h>
#include <hip/hip_cooperative_groups.h>
#include <cstdio>
#include <cstdint>
namespace cg = cooperative_groups;

#define LAS __attribute__((address_space(3)))
typedef unsigned short bf16_t;
typedef short bf16x8 __attribute__((ext_vector_type(8)));
typedef float f32x4 __attribute__((ext_vector_type(4)));
typedef float f32x16 __attribute__((ext_vector_type(16)));
typedef unsigned u32x4 __attribute__((ext_vector_type(4)));
typedef unsigned u32x2 __attribute__((ext_vector_type(2)));

constexpr int DM = 2048, BATCH = 8, SEQ = 4096, MROWS = BATCH * SEQ, FF = 8192;
constexpr int NIN_E = 2304;
constexpr float RMS_EPS = 1e-6f;
constexpr float QSCALE = 0.07216878364870322f * 1.4426950408889634f;

constexpr size_t MiB = 1u << 20;
constexpr size_t WS_SSQX = 1 * MiB;
constexpr size_t WS_SSQC = 5 * MiB;
constexpr size_t WS_ROPE = 8 * MiB;
constexpr size_t WS_W = 16 * MiB;
constexpr size_t W_UP = WS_W, W_DOWN = WS_W + 128 * MiB, W_INE = WS_W + 256 * MiB, W_UQ = WS_W + 274 * MiB, W_UKV = WS_W + 277 * MiB,
                 W_POOL = WS_W + 281 * MiB, W_OUTE = WS_W + 282 * MiB, W_INO = WS_W + 298 * MiB, W_OUTO = WS_W + 346 * MiB;
constexpr size_t WS_XB = 378 * MiB;
constexpr size_t WS_H = 506 * MiB;
constexpr size_t H_CU = WS_H, H_KROPE = WS_H, H_VT = WS_H + 368 * MiB, H_KR = WS_H + 128 * MiB, H_MIX = WS_H + 144 * MiB, H_QROPE = WS_H + 272 * MiB,
                 H_KV = WS_H + 304 * MiB, H_POOLED = WS_H + 432 * MiB, H_VB = WS_H, H_BG = WS_H + 128 * MiB, H_G = WS_H + 384 * MiB;
constexpr size_t WS_END = 1018 * MiB;

constexpr int LDS_BYTES = 163840;
#ifndef FP8_DOWN_MASK
#define FP8_DOWN_MASK 0
#endif
constexpr float F8_SCALE_H = 4.0f, F8_SCALE_W = 4096.0f, F8_UNSCALE = 1.0f / (4.0f * 4096.0f);
typedef int i32x4 __attribute__((ext_vector_type(4)));
typedef int i32x8 __attribute__((ext_vector_type(8)));
__device__ __forceinline__ unsigned pk4_fp8(float a, float b, float c, float d) {
    a = fminf(fmaxf(a, -448.f), 448.f); b = fminf(fmaxf(b, -448.f), 448.f); c = fminf(fmaxf(c, -448.f), 448.f); d = fminf(fmaxf(d, -448.f), 448.f);
    int r = 0; r = __builtin_amdgcn_cvt_pk_fp8_f32(a, b, r, false); r = __builtin_amdgcn_cvt_pk_fp8_f32(c, d, r, true); return (unsigned)r; }

__device__ __forceinline__ unsigned cvt_pk_bf16(float lo, float hi) { unsigned r; asm volatile("v_cvt_pk_bf16_f32 %0, %1, %2" : "=v"(r) : "v"(lo), "v"(hi)); return r; }
__device__ __forceinline__ float bf_lo(unsigned u) { return __uint_as_float(u << 16); }
__device__ __forceinline__ float bf_hi(unsigned u) { return __uint_as_float(u & 0xffff0000u); }

__device__ __forceinline__ int fresh_tid(int wv) {
    unsigned m = ~0u; asm volatile("" : "+s"(m));
    int t = wv * 64 + (int)__builtin_amdgcn_mbcnt_hi(m, __builtin_amdgcn_mbcnt_lo(m, 0u)); asm volatile("" : "+v"(t)); return t; }

__device__ __forceinline__ float sum_x16(float s) { auto r = __builtin_amdgcn_permlane16_swap(__float_as_uint(s), __float_as_uint(s), false, false); return __uint_as_float(r[0]) + __uint_as_float(r[1]); }
__device__ __forceinline__ float sum_x32(float s) { auto r = __builtin_amdgcn_permlane32_swap(__float_as_uint(s), __float_as_uint(s), false, false); return __uint_as_float(r[0]) + __uint_as_float(r[1]); }
__device__ __forceinline__ float max_x32(float s) { auto r = __builtin_amdgcn_permlane32_swap(__float_as_uint(s), __float_as_uint(s), false, false); return fmaxf(__uint_as_float(r[0]), __uint_as_float(r[1])); }
__device__ __forceinline__ float shx(float v, int k, int lane) { return __uint_as_float((unsigned)__builtin_amdgcn_ds_bpermute((lane ^ k) << 2, (int)__float_as_uint(v))); }

namespace pg8 {
constexpr int BM = 256, BK = 64, HALF = 128, HTB = HALF * BK * 2, STAGE_BYTES = 8 * HTB, NXCD = 8, WGM = 8;
__host__ __device__ __forceinline__ int lds_byte(int r, int c) { const int st = (r >> 4) * 2 + (c >> 5), rr = r & 15, cc = c & 31, ob = rr * 64 + cc * 2; return st * 1024 + (ob ^ (((ob >> 9) & 1) << 5)); }
__host__ __device__ __forceinline__ void stage_rc(int b, int& R, int& C) { const int st = b / 1024, sb = b % 1024, swz = sb ^ (((sb >> 9) & 1) << 5); R = (st >> 1) * 16 + swz / 64; C = (st & 1) * 32 + (swz % 64) / 2; }
__host__ __device__ __forceinline__ int perm32(int rho) { const int n = rho >> 4, i = rho & 15; return 8 * (i >> 2) + 4 * n + (i & 3); }

struct Unit { int pm, pn; };
constexpr int RS_LDS_OFF = 132096;
template <int NP, int DIM> __device__ __forceinline__ void load_rs8(const float* ssq, const Unit& u, int wr, int fr, int fq, float (&rs)[8]) {
#pragma unroll
    for (int k = 0; k < 8; ++k) { const int row = u.pm * BM + wr * 64 + fr + (k >> 2) * HALF + (k & 3) * 16; float s = 0.f;
#pragma unroll
        for (int q = 0; q < NP / 4; ++q) s += ssq[(size_t)(fq + 4 * q) * MROWS + row];
        s = sum_x16(s); s = sum_x32(s); rs[k] = 1.0f / sqrtf(s * (1.0f / (float)DIM) + RMS_EPS); }
}
template <int N_, int WG = WGM> struct StaticOrder {
    int G, c;
    static constexpr int nM = MROWS / BM, nN = N_ / BM, nwg = nM * nN;
    __device__ __forceinline__ bool next(int i, Unit& u) const {
        const int L = i * G + c; if (L >= nwg) return false;
        int wgid = L; { constexpr int q = nwg / NXCD, r = nwg % NXCD; const int xcd = wgid % NXCD, off = wgid / NXCD; wgid = (xcd < r ? xcd * (q + 1) : r * (q + 1) + (xcd - r) * q) + off; }
        constexpr int nig = WG * nN; const int gid = wgid / nig, fm = gid * WG, gsz = (nM - fm) < WG ? (nM - fm) : WG;
        u.pm = fm + ((wgid % nig) % gsz); u.pn = (wgid % nig) / gsz; return true;
    }
};

template <int NP_IN, int DIM, int ACT, int SSQ_LIM, int SPLIT, int LDC0, int LDC1, bool OUT_FP8 = false> struct EpiB {
    bf16_t* O0; bf16_t* O1; const float* ssq_in; float* ssq_out;
    static constexpr bool HAS_RS = NP_IN > 0;
    __device__ __forceinline__ void load_rs(const Unit& u, int wr, int fr, int fq, float (&rs)[8]) const { if constexpr (NP_IN > 0) load_rs8<NP_IN, DIM>(ssq_in, u, wr, fr, fq, rs); }
    __device__ __forceinline__ void operator()(const f32x4 (&acc)[2][2][4][2], const Unit& u, int wr, int wc, int fr, int fq, const float (&rsv)[8]) const {
        const int rowb = u.pm * BM + wr * 64 + fr;
        int pn = u.pn; bf16_t* O = O0; int ldc = LDC0;
        if (SPLIT < 64 && pn >= SPLIT) { pn -= SPLIT; O = O1; ldc = LDC1; }
        const int col0 = pn * BM + wc * 32 + 8 * fq;
        const bool do_ssq = (SSQ_LIM > 0) && (u.pn < SSQ_LIM);
#pragma unroll
        for (int ai = 0; ai < 2; ++ai)
#pragma unroll
            for (int m = 0; m < 4; ++m) {
                const int row = rowb + ai * HALF + m * 16;
                const float rs = (NP_IN > 0) ? rsv[ai * 4 + m] : 1.f;
                float sq = 0.f;
#pragma unroll
                for (int bj = 0; bj < 2; ++bj) {
                    f32x4 v0 = acc[ai][bj][m][0] * rs, v1 = acc[ai][bj][m][1] * rs;
                    if (ACT) {
#pragma unroll
                        for (int i = 0; i < 4; ++i) { float a = fmaxf(v0[i], 0.f), b = fmaxf(v1[i], 0.f); v0[i] = a * a; v1[i] = b * b; }
                    }
                    if (SSQ_LIM > 0) sq += (v0[0] * v0[0] + v0[1] * v0[1]) + (v0[2] * v0[2] + v0[3] * v0[3]) + (v1[0] * v1[0] + v1[1] * v1[1]) + (v1[2] * v1[2] + v1[3] * v1[3]);
                    if (OUT_FP8) {
                        u32x2 w8; w8.x = pk4_fp8(v0[0] * F8_SCALE_H, v0[1] * F8_SCALE_H, v0[2] * F8_SCALE_H, v0[3] * F8_SCALE_H); w8.y = pk4_fp8(v1[0] * F8_SCALE_H, v1[1] * F8_SCALE_H, v1[2] * F8_SCALE_H, v1[3] * F8_SCALE_H);
                        *(u32x2*)((unsigned char*)O + (size_t)row * ldc + col0 + bj * HALF) = w8;
                    } else {
                    u32x4 w; w.x = cvt_pk_bf16(v0[0], v0[1]); w.y = cvt_pk_bf16(v0[2], v0[3]); w.z = cvt_pk_bf16(v1[0], v1[1]); w.w = cvt_pk_bf16(v1[2], v1[3]);
                    *(u32x4*)(O + (size_t)row * ldc + col0 + bj * HALF) = w;
                    }
                }
                if (do_ssq) {
                    sq = sum_x16(sq); sq = sum_x32(sq);
                    if (fq == 0) ssq_out[(size_t)(u.pn * 4 + wc) * MROWS + row] = sq;
                }
            }
    }
};
struct EpiR {
    const float* base; float* outf; bf16_t* XB; float* ssq_out; float ascale;
    static constexpr bool HAS_RS = false;
    __device__ __forceinline__ void load_rs(const Unit&, int, int, int, float (&)[8]) const {}
    __device__ __forceinline__ void operator()(const f32x4 (&acc)[2][2][4][2], const Unit& u, int wr, int wc, int fr, int fq, const float (&)[8]) const {
        const int rowb = u.pm * BM + wr * 64 + fr;
        const int col0 = u.pn * BM + wc * 32 + 8 * fq;
#pragma unroll
        for (int ai = 0; ai < 2; ++ai) {
            f32x4 pre[4][2][2];
#pragma unroll
            for (int m = 0; m < 4; ++m)
#pragma unroll
                for (int bj = 0; bj < 2; ++bj) { const size_t off = (size_t)(rowb + ai * HALF + m * 16) * DM + col0 + bj * HALF;
                    pre[m][bj][0] = *(const f32x4*)(base + off); pre[m][bj][1] = *(const f32x4*)(base + off + 4); }
#pragma unroll
            for (int m = 0; m < 4; ++m) {
                const int row = rowb + ai * HALF + m * 16;
                float sq = 0.f;
#pragma unroll
                for (int bj = 0; bj < 2; ++bj) {
                    const size_t off = (size_t)row * DM + col0 + bj * HALF;
                    const f32x4 v0 = acc[ai][bj][m][0] * ascale + pre[m][bj][0], v1 = acc[ai][bj][m][1] * ascale + pre[m][bj][1];
                    *(f32x4*)(outf + off) = v0; *(f32x4*)(outf + off + 4) = v1;
                    sq += (v0[0] * v0[0] + v0[1] * v0[1]) + (v0[2] * v0[2] + v0[3] * v0[3]) + (v1[0] * v1[0] + v1[1] * v1[1]) + (v1[2] * v1[2] + v1[3] * v1[3]);
                    u32x4 w; w.x = cvt_pk_bf16(v0[0], v0[1]); w.y = cvt_pk_bf16(v0[2], v0[3]); w.z = cvt_pk_bf16(v1[0], v1[1]); w.w = cvt_pk_bf16(v1[2], v1[3]);
                    *(u32x4*)(XB + off) = w;
                }
                sq = sum_x16(sq); sq = sum_x32(sq);
                if (fq == 0) ssq_out[(size_t)(u.pn * 4 + wc) * MROWS + row] = sq;
            }
            asm volatile("" ::: "memory");
        }
    }
};

struct EpiCU {
    bf16_t* VB; bf16_t* BG; const float* ssq_in;
    static constexpr bool HAS_RS = true;
    __device__ __forceinline__ void load_rs(const Unit& u, int wr, int fr, int fq, float (&rs)[8]) const { load_rs8<32, 2048>(ssq_in, u, wr, fr, fq, rs); }
    __device__ __forceinline__ void operator()(const f32x4 (&acc)[2][2][4][2], const Unit& u, int wr, int wc, int fr, int fq, const float (&rsv)[8]) const {
        const int rowb = u.pm * BM + wr * 64 + fr;
#pragma unroll
        for (int ai = 0; ai < 2; ++ai)
#pragma unroll
            for (int m = 0; m < 4; ++m) {
                const int row = rowb + ai * HALF + m * 16;
                const float rs = rsv[ai * 4 + m];
                if (u.pn < 16) {
                    const f32x4 c0 = acc[ai][0][m][0] * rs, c1 = acc[ai][0][m][1] * rs, u0 = acc[ai][1][m][0] * rs, u1 = acc[ai][1][m][1] * rs;
                    const f32x4 v0 = c0 * u0, v1 = c1 * u1;
                    u32x4 w; w.x = cvt_pk_bf16(v0[0], v0[1]); w.y = cvt_pk_bf16(v0[2], v0[3]); w.z = cvt_pk_bf16(v1[0], v1[1]); w.w = cvt_pk_bf16(v1[2], v1[3]);
                    *(u32x4*)(VB + (size_t)row * DM + u.pn * HALF + wc * 32 + 8 * fq) = w;
                } else {
#pragma unroll
                    for (int bj = 0; bj < 2; ++bj) { const f32x4 v0 = acc[ai][bj][m][0] * rs, v1 = acc[ai][bj][m][1] * rs;
                        u32x4 w; w.x = cvt_pk_bf16(v0[0], v0[1]); w.y = cvt_pk_bf16(v0[2], v0[3]); w.z = cvt_pk_bf16(v1[0], v1[1]); w.w = cvt_pk_bf16(v1[2], v1[3]);
                        *(u32x4*)(BG + (size_t)row * DM + (u.pn - 16) * BM + bj * HALF + wc * 32 + 8 * fq) = w; }
                }
            }
    }
};

struct EpiKV {
    bf16_t* KN; bf16_t* VT; const float* ssq_in;
    static constexpr bool HAS_RS = true;
    __device__ __forceinline__ void load_rs(const Unit& u, int wr, int fr, int fq, float (&rs)[8]) const { load_rs8<8, 512>(ssq_in, u, wr, fr, fq, rs); }
    __device__ __forceinline__ void operator()(const f32x4 (&acc)[2][2][4][2], const Unit& u, int wr, int wc, int fr, int fq, const float (&rsv)[8]) const {
        const int rowb = u.pm * BM + wr * 64 + fr;
#pragma unroll
        for (int ai = 0; ai < 2; ++ai)
#pragma unroll
            for (int m = 0; m < 4; ++m) {
                const int row = rowb + ai * HALF + m * 16;
                const float rs = rsv[ai * 4 + m];
                if (u.pn < 4) {
#pragma unroll
                    for (int bj = 0; bj < 2; ++bj) { const f32x4 v0 = acc[ai][bj][m][0] * rs, v1 = acc[ai][bj][m][1] * rs;
                        u32x4 w; w.x = cvt_pk_bf16(v0[0], v0[1]); w.y = cvt_pk_bf16(v0[2], v0[3]); w.z = cvt_pk_bf16(v1[0], v1[1]); w.w = cvt_pk_bf16(v1[2], v1[3]);
                        *(u32x4*)(KN + (size_t)row * 1024 + u.pn * BM + bj * HALF + wc * 32 + 8 * fq) = w; }
                } else {
                    const int b = row >> 12, sq = row & (SEQ - 1);
#pragma unroll
                    for (int bj = 0; bj < 2; ++bj) { const f32x4 v0 = acc[ai][bj][m][0] * rs, v1 = acc[ai][bj][m][1] * rs;
                        const int h = (u.pn - 4) * 2 + bj, dv0 = wc * 32 + 8 * fq;
                        bf16_t* vp = VT + ((size_t)(b * 8 + h) * 128 + dv0) * SEQ + sq;
                        const unsigned w0 = cvt_pk_bf16(v0[0], v0[1]), w1 = cvt_pk_bf16(v0[2], v0[3]), w2 = cvt_pk_bf16(v1[0], v1[1]), w3 = cvt_pk_bf16(v1[2], v1[3]);
                        vp[0 * SEQ] = (bf16_t)(w0 & 0xffffu); vp[1 * SEQ] = (bf16_t)(w0 >> 16); vp[2 * SEQ] = (bf16_t)(w1 & 0xffffu); vp[3 * SEQ] = (bf16_t)(w1 >> 16);
                        vp[4 * SEQ] = (bf16_t)(w2 & 0xffffu); vp[5 * SEQ] = (bf16_t)(w2 >> 16); vp[6 * SEQ] = (bf16_t)(w3 & 0xffffu); vp[7 * SEQ] = (bf16_t)(w3 >> 16); }
                }
            }
    }
};

template <int N_, int K_, int LDA, int LDB, int APN, bool FP8 = false, int WG = WGM, class EpiT>
__device__ __forceinline__ void gemm_phase(LAS unsigned char* lds, const bf16_t* gA, const bf16_t* gBt, int G, int bid, int wv, const EpiT& E) {
    StaticOrder<N_, WG> S; S.G = G; S.c = bid;
    const int tid = fresh_tid(wv), wid = __builtin_amdgcn_readfirstlane(tid >> 6), lane = tid & 63, wr = wid >> 2, wc = wid & 3, fr = lane & 15, fq = lane >> 4;
    constexpr int nt = K_ / BK;
    unsigned voffA[2], voffB[2];
#pragma unroll
    for (int i = 0; i < 2; ++i) { int R, C; stage_rc(tid * 16 + i * 8192, R, C); const int Rb = (R & ~31) + perm32(R & 31);
        voffA[i] = (unsigned)(R * LDA + C) * 2u; voffB[i] = (unsigned)(Rb * LDB + C) * 2u; }
    constexpr size_t kstep = (size_t)(BK * 2);
    constexpr size_t hstepA = (size_t)HALF * LDA * 2, hstepB = (size_t)HALF * LDB * 2;
    constexpr size_t tstepA = 2 * hstepA, tstepB = 2 * hstepB;
    const unsigned ldsw = (unsigned)wid * 1024u;
    const unsigned ldsbase = (unsigned)__builtin_amdgcn_readfirstlane((int)((unsigned)(uintptr_t)lds + ldsw));
    const int aoff = lds_byte(wr * 64 + fr, fq * 8), boff = lds_byte(wc * 32 + fr, fq * 8);
#define PG8_SA(b, h) (((b) * 2 + (h)) * HTB)
#define PG8_SB(b, h) ((4 + (b) * 2 + (h)) * HTB)
#define PG8_STAGE(bufoff, gbase, voff) do { _Pragma("unroll") for (int _i = 0; _i < 2; ++_i) { \
        if constexpr (true) { unsigned keep_; const char* gb_ = (const char*)(gbase);   \
            asm volatile("s_mov_b32 %0, m0\n\ts_mov_b32 m0, %3\n\ts_nop 0\n\tglobal_load_lds_dwordx4 %1, %2\n\ts_mov_b32 m0, %0" : "=&s"(keep_) : "v"((voff)[_i]), "s"(gb_), "s"(ldsbase + (unsigned)((bufoff) + _i * 8192)) : "memory"); } \
        else __builtin_amdgcn_global_load_lds((const unsigned*)((const char*)(gbase) + (voff)[_i]), (LAS unsigned*)(lds + (bufoff) + ldsw + _i * 8192), 16, 0, 0); } } while (0)
#define PG8_LDA(dst, b, h) do { _Pragma("unroll") for (int m = 0; m < 4; ++m) _Pragma("unroll") for (int k = 0; k < 2; ++k) dst[m][k] = *(const LAS bf16x8*)(lds + PG8_SA(b, h) + aoff + m * 2048 + k * 1024); } while (0)
#define PG8_LDB(dst, b, h) do { _Pragma("unroll") for (int n = 0; n < 2; ++n) _Pragma("unroll") for (int k = 0; k < 2; ++k) dst[n][k] = *(const LAS bf16x8*)(lds + PG8_SB(b, h) + boff + n * 2048 + k * 1024); } while (0)
#define PG8_CAT(x, y) __builtin_shufflevector(__builtin_bit_cast(i32x4, x), __builtin_bit_cast(i32x4, y), 0, 1, 2, 3, 4, 5, 6, 7)
#define PG8_MMA(ai, bj, At, Bt) do { __builtin_amdgcn_s_setprio(1); _Pragma("unroll") for (int m = 0; m < 4; ++m) _Pragma("unroll") for (int n = 0; n < 2; ++n) { \
        if constexpr (FP8) { acc[ai][bj][m][n] = __builtin_amdgcn_mfma_scale_f32_16x16x128_f8f6f4(PG8_CAT(Bt[n][0], Bt[n][1]), PG8_CAT(At[m][0], At[m][1]), acc[ai][bj][m][n], 0, 0, 0, 0, 0, 0); } \
        else { _Pragma("unroll") for (int k = 0; k < 2; ++k) acc[ai][bj][m][n] = __builtin_amdgcn_mfma_f32_16x16x32_bf16(Bt[n][k], At[m][k], acc[ai][bj][m][n], 0, 0, 0); } } \
        __builtin_amdgcn_s_setprio(0); } while (0)
#define PG8_WAIT_V(n) asm volatile("s_waitcnt vmcnt(" #n ")" ::: "memory")
#define PG8_WAIT_L(n) asm volatile("s_waitcnt lgkmcnt(" #n ")" ::: "memory")
#define PG8_BAR __builtin_amdgcn_s_barrier()
#define PG8_SCHED __builtin_amdgcn_sched_barrier(0)
    Unit cur, nxt; int ui = 0;
    if (!S.next(0, cur)) return;
    LAS f32x4* rs_slot = (LAS f32x4*)(lds + RS_LDS_OFF + (wid * 64 + lane) * 32);
    f32x4 acc[2][2][4][2];
#pragma unroll
    for (int a = 0; a < 2; ++a)
#pragma unroll
        for (int b = 0; b < 2; ++b)
#pragma unroll
            for (int m = 0; m < 4; ++m)
#pragma unroll
                for (int n = 0; n < 2; ++n) acc[a][b][m][n] = (f32x4){0.f, 0.f, 0.f, 0.f};
    bf16x8 At[4][2], B0[2][2], B1[2][2];
    const char* cA = (const char*)gA + (size_t)cur.pm * tstepA + (size_t)cur.pn * APN; const char* cB = (const char*)gBt + (size_t)cur.pn * tstepB;
    PG8_STAGE(PG8_SB(0, 0), cB, voffB); PG8_STAGE(PG8_SB(0, 1), cB + hstepB, voffB); PG8_STAGE(PG8_SA(0, 0), cA, voffA); PG8_STAGE(PG8_SA(0, 1), cA + hstepA, voffA);
    if constexpr (EpiT::HAS_RS) { float r0[8]; E.load_rs(cur, wr, fr, fq, r0);
        rs_slot[0] = (f32x4){r0[0], r0[1], r0[2], r0[3]}; rs_slot[1] = (f32x4){r0[4], r0[5], r0[6], r0[7]}; }
    if (wr == 1) PG8_BAR;
    PG8_WAIT_V(2); PG8_BAR;
    PG8_STAGE(PG8_SB(1, 0), cB + kstep, voffB); PG8_STAGE(PG8_SA(1, 0), cA + kstep, voffA); PG8_STAGE(PG8_SB(1, 1), cB + hstepB + kstep, voffB);
    PG8_WAIT_V(6); PG8_BAR;
    for (;;) {
        const bool has_next = S.next(ui + 1, nxt);
        const char* nA = has_next ? (const char*)gA + (size_t)nxt.pm * tstepA + (size_t)nxt.pn * APN : cA; const char* nB = has_next ? (const char*)gBt + (size_t)nxt.pn * tstepB : cB;
        for (int t = 0; t < nt; t += 2) {
            const bool last = (t == nt - 2);
            const char* a1 = cA + (size_t)(t + 1) * kstep;
            const char* a2 = last ? nA : cA + (size_t)(t + 2) * kstep; const char* b2 = last ? nB : cB + (size_t)(t + 2) * kstep;
            const char* a3 = a2 + kstep; const char* b3 = b2 + kstep;
            PG8_LDB(B0, 0, 0); PG8_LDB(B1, 0, 1); PG8_SCHED; PG8_LDA(At, 0, 0); PG8_STAGE(PG8_SA(1, 1), a1 + hstepA, voffA);
            PG8_WAIT_V(8); PG8_WAIT_L(0); PG8_BAR; PG8_MMA(0, 0, At, B0); PG8_MMA(0, 1, At, B1); PG8_BAR; PG8_SCHED;
            PG8_LDA(At, 0, 1); PG8_STAGE(PG8_SB(0, 0), b2, voffB); PG8_STAGE(PG8_SB(0, 1), b2 + hstepB, voffB); PG8_STAGE(PG8_SA(0, 0), a2, voffA);
            PG8_WAIT_V(8); PG8_WAIT_L(0); PG8_BAR; PG8_MMA(1, 0, At, B0); PG8_MMA(1, 1, At, B1); PG8_BAR; PG8_SCHED;
            PG8_LDB(B0, 1, 0); PG8_LDB(B1, 1, 1); PG8_SCHED; PG8_LDA(At, 1, 0); PG8_STAGE(PG8_SA(0, 1), a2 + hstepA, voffA);
            PG8_WAIT_V(8); PG8_WAIT_L(0); PG8_BAR; PG8_MMA(0, 0, At, B0); PG8_MMA(0, 1, At, B1); PG8_BAR; PG8_SCHED;
            PG8_LDA(At, 1, 1); PG8_STAGE(PG8_SB(1, 0), b3, voffB); PG8_STAGE(PG8_SB(1, 1), b3 + hstepB, voffB); PG8_STAGE(PG8_SA(1, 0), a3, voffA);
            PG8_WAIT_V(8); PG8_WAIT_L(0); PG8_BAR; PG8_MMA(1, 0, At, B0); PG8_MMA(1, 1, At, B1); PG8_BAR; PG8_SCHED;
        }
        if (wr == 0) PG8_BAR;
        { const int l2 = fresh_tid(wv) & 63; float rsv[8];
          if constexpr (EpiT::HAS_RS) { const f32x4 a = rs_slot[0], b = rs_slot[1]; rsv[0] = a[0]; rsv[1] = a[1]; rsv[2] = a[2]; rsv[3] = a[3]; rsv[4] = b[0]; rsv[5] = b[1]; rsv[6] = b[2]; rsv[7] = b[3]; }
          E(acc, cur, wr, wc, l2 & 15, l2 >> 4, rsv);
          if constexpr (EpiT::HAS_RS) { if (has_next) { float r1[8]; E.load_rs(nxt, wr, l2 & 15, l2 >> 4, r1);
              rs_slot[0] = (f32x4){r1[0], r1[1], r1[2], r1[3]}; rs_slot[1] = (f32x4){r1[4], r1[5], r1[6], r1[7]}; } } }
        if (!has_next) break;
#pragma unroll
        for (int a = 0; a < 2; ++a)
#pragma unroll
            for (int b = 0; b < 2; ++b)
#pragma unroll
                for (int m = 0; m < 4; ++m)
#pragma unroll
                    for (int n = 0; n < 2; ++n) acc[a][b][m][n] = (f32x4){0.f, 0.f, 0.f, 0.f};
        cur = nxt; cA = nA; cB = nB; ++ui;
        if (wr == 1) PG8_BAR;
    }
    PG8_WAIT_V(0);
    PG8_BAR;
#undef PG8_SA
#undef PG8_SB
#undef PG8_STAGE
#undef PG8_LDA
#undef PG8_LDB
#undef PG8_MMA
#undef PG8_CAT
#undef PG8_WAIT_V
#undef PG8_WAIT_L
#undef PG8_BAR
#undef PG8_SCHED
}
}

struct Args {
    const float* x; const int* pos; const float* mix_g; const float* mlp_g; const float* w_up; const float* w_down;
    const float* e_w_in; const float* e_qa_g; const float* e_kva_g; const float* e_w_uq; const float* e_w_ukv; const float* e_qn_g; const float* e_kn_g;
    const float* e_pool_w; const float* e_pool_s; const float* e_w_out; const float* o_w_in; const float* o_conv_w; const float* o_w_out;
    float* out; unsigned char* ws;
};

__device__ __forceinline__ int maprow(int kind, int n0) {
    if (kind == 1) { return n0 < 1024 ? n0 : (n0 < 1088 ? 2048 + (n0 - 1024) : 1024 + (n0 - 1088)); }
    if (kind == 2) { const int h = n0 / 192, d = n0 % 192; return d < 128 ? h * 128 + d : 1024 + h * 64 + (d - 128); }
    if (kind == 3) { const int h = n0 / 256, d = n0 % 256; return d < 128 ? h * 128 + d : 1024 + h * 128 + (d - 128); }
    if (kind == 4) {
        if (n0 < 2048) return 4096 + n0;
        if (n0 < 4096) { const int ch = n0 - 2048; return 256 * (ch >> 7) + (ch & 127); }
        const int ch = n0 - 4096; return 256 * (ch >> 7) + 128 + (ch & 127); }
    return n0;
}
__device__ __forceinline__ void conv_item(const float* W, int K, int N, const float* gain, const float* nscale, bf16_t* WT, int kind, LAS float* scr, int item, int lane, int f8) {
    const int nblk = N >> 6, kb = item / nblk, nb = item - kb * nblk, k0 = kb * 64, n0 = nb * 64;
    const int r4 = lane >> 4, c4 = (lane & 15) * 4;
    const float* wp = W + (size_t)(k0 + r4) * N + n0 + c4;
    f32x4 v[16];
#pragma unroll
    for (int i = 0; i < 16; ++i) v[i] = *(const f32x4*)(wp + (size_t)(4 * i) * N);
    f32x4 ns = (f32x4){1.f, 1.f, 1.f, 1.f};
    if (nscale) ns = *(const f32x4*)(nscale + n0 + c4);
    float g[16];
#pragma unroll
    for (int i = 0; i < 16; ++i) g[i] = gain ? gain[k0 + 4 * i + r4] : 1.f;
#pragma unroll
    for (int i = 0; i < 16; ++i) { LAS float* sp = scr + (4 * i + r4) * 65 + c4; const f32x4 t = v[i] * ns * g[i]; sp[0] = t.x; sp[1] = t.y; sp[2] = t.z; sp[3] = t.w; }
    asm volatile("s_waitcnt lgkmcnt(0)" ::: "memory");
    const int c = lane & 7, drow0 = maprow(kind, n0);
#pragma unroll
    for (int j = 0; j < 8; ++j) { const int n = (lane >> 3) + 8 * j; const LAS float* s = scr + (8 * c) * 65 + n;
        if (f8) {
            u32x2 o8; o8.x = pk4_fp8(s[0 * 65] * F8_SCALE_W, s[1 * 65] * F8_SCALE_W, s[2 * 65] * F8_SCALE_W, s[3 * 65] * F8_SCALE_W); o8.y = pk4_fp8(s[4 * 65] * F8_SCALE_W, s[5 * 65] * F8_SCALE_W, s[6 * 65] * F8_SCALE_W, s[7 * 65] * F8_SCALE_W);
            *(u32x2*)((unsigned char*)WT + (size_t)(drow0 + n) * K + k0 + 8 * c) = o8;
        } else {
        u32x4 o; o.x = cvt_pk_bf16(s[0 * 65], s[1 * 65]); o.y = cvt_pk_bf16(s[2 * 65], s[3 * 65]); o.z = cvt_pk_bf16(s[4 * 65], s[5 * 65]); o.w = cvt_pk_bf16(s[6 * 65], s[7 * 65]);
        *(u32x4*)(WT + (size_t)(drow0 + n) * K + k0 + 8 * c) = o; } }
    asm volatile("s_waitcnt lgkmcnt(0)" ::: "memory");
}

struct ConvJob { const float* src; const float* gain; const float* nscale; bf16_t* dst; int K, N, kind, items, f8; };
__device__ __forceinline__ ConvJob get_job(int j, const Args& a) {
    ConvJob J; J.gain = nullptr; J.nscale = nullptr; J.kind = 0; J.f8 = 0;
    unsigned char* ws = a.ws;
    if (j < 8) { const int l = j >> 1;
        if ((j & 1) == 0) { J.src = a.w_up + (size_t)l * DM * FF; J.K = DM; J.N = FF; J.gain = a.mlp_g + l * DM; J.dst = (bf16_t*)(ws + W_UP) + (size_t)l * DM * FF; }
        else { J.src = a.w_down + (size_t)l * DM * FF; J.K = FF; J.N = DM; J.dst = (bf16_t*)(ws + W_DOWN) + (size_t)l * DM * FF; J.f8 = (FP8_DOWN_MASK >> l) & 1; }
    } else if (j < 24) { const int e = (j - 8) >> 3, t = (j - 8) & 7;
        if (t == 0) { J.src = a.e_w_in + (size_t)e * DM * 2112; J.K = DM; J.N = 2112; J.gain = a.mix_g + (2 * e) * DM; J.kind = 1; J.dst = (bf16_t*)(ws + W_INE) + (size_t)e * NIN_E * DM; }
        else if (t == 1) { J.src = a.e_w_uq + (size_t)e * 512 * 1536; J.K = 512; J.N = 1536; J.gain = a.e_qa_g + e * 512; J.kind = 2; J.dst = (bf16_t*)(ws + W_UQ) + (size_t)e * 1536 * 512; }
        else if (t == 2) { J.src = a.e_w_ukv + (size_t)e * 512 * 2048; J.K = 512; J.N = 2048; J.gain = a.e_kva_g + e * 512; J.kind = 3; J.dst = (bf16_t*)(ws + W_UKV) + (size_t)e * 2048 * 512; }
        else if (t < 7) { const int gq = t - 3; J.src = a.e_pool_w + (size_t)(e * 4 + gq) * 65536; J.K = 256; J.N = 256; J.nscale = a.e_pool_s + e * 1024 + gq * 256; J.dst = (bf16_t*)(ws + W_POOL) + (size_t)(e * 4 + gq) * 65536; }
        else { J.src = a.e_w_out + (size_t)e * DM * DM; J.K = DM; J.N = DM; J.dst = (bf16_t*)(ws + W_OUTE) + (size_t)e * DM * DM; }
    } else { const int o = (j - 24) >> 1;
        if (((j - 24) & 1) == 0) { J.src = a.o_w_in + (size_t)o * DM * 6144; J.K = DM; J.N = 6144; J.gain = a.mix_g + (2 * o + 1) * DM; J.kind = 4; J.dst = (bf16_t*)(ws + W_INO) + (size_t)o * 6144 * DM; }
        else { J.src = a.o_w_out + (size_t)o * DM * DM; J.K = DM; J.N = DM; J.dst = (bf16_t*)(ws + W_OUTO) + (size_t)o * DM * DM; }
    }
    J.items = (J.K / 64) * (J.N / 64);
    return J;
}

__device__ __forceinline__ void prologue(const Args& a, LAS unsigned char* lds, int gw, int NGW, int lane, int wave) {
    LAS float* scr = (LAS float*)(lds + wave * 16640);
    unsigned char* ws = a.ws;
    constexpr int NITEMS = 4 * (4096 + 4096) + 2 * (1056 + 192 + 256 + 4 * 16 + 1024) + 2 * (3072 + 1024);
    for (int it = gw; it < NITEMS; it += NGW) {
        int r = it, j = 0; ConvJob J = get_job(0, a);
        while (r >= J.items) { r -= J.items; ++j; J = get_job(j, a); }
        conv_item(J.src, J.K, J.N, J.gain, J.nscale, J.dst, J.kind, scr, r, lane, J.f8);
    }
    {
        const int gt = gw * 64 + lane, NGT = NGW * 64;
        for (int e = 0; e < 2; ++e) { u32x4* p = (u32x4*)((bf16_t*)(ws + W_INE) + (size_t)e * NIN_E * DM + (size_t)2112 * DM);
            for (int i = gt; i < 192 * DM / 8; i += NGT) p[i] = (u32x4){0u, 0u, 0u, 0u}; }
        float* rope = (float*)(ws + WS_ROPE);
        for (int i = gt; i < MROWS * 32; i += NGT) { const int m = i >> 5, f = i & 31;
            const float inv = __builtin_amdgcn_exp2f(-(float)f * (13.287712379549449f / 32.0f));
            const float ang = (float)a.pos[m] * inv;
            double rev = (double)ang * 0.15915494309189535; rev -= __builtin_floor(rev);
            const float rf = (float)rev;
            rope[(size_t)m * 64 + f] = __builtin_amdgcn_cosf(rf); rope[(size_t)m * 64 + 32 + f] = __builtin_amdgcn_sinf(rf); }
    }
    bf16_t* XB = (bf16_t*)(ws + WS_XB); float* ssqx = (float*)(ws + WS_SSQX);
    for (int m = gw * 2; m < MROWS; m += NGW * 2) {
        const f32x4* xr = (const f32x4*)(a.x + (size_t)m * DM) + lane;
        f32x4 v[16];
#pragma unroll
        for (int j = 0; j < 16; ++j) v[j] = xr[64 * j];
        u32x2* o8 = (u32x2*)(XB + (size_t)m * DM) + lane;
        float s0 = 0.f, s1 = 0.f;
#pragma unroll
        for (int j = 0; j < 16; ++j) { const float q = (v[j].x * v[j].x + v[j].y * v[j].y) + (v[j].z * v[j].z + v[j].w * v[j].w); if (j < 8) s0 += q; else s1 += q;
            u32x2 w; w.x = cvt_pk_bf16(v[j].x, v[j].y); w.y = cvt_pk_bf16(v[j].z, v[j].w); o8[64 * j] = w; }
#pragma unroll
        for (int o = 1; o < 64; o <<= 1) { s0 += shx(s0, o, lane); s1 += shx(s1, o, lane); }
        if (lane < 32) { ssqx[(size_t)lane * MROWS + m] = (lane == 0) ? s0 : 0.f; ssqx[(size_t)lane * MROWS + m + 1] = (lane == 0) ? s1 : 0.f; }
    }
}

__device__ __forceinline__ void unpack8(const u32x4 v, float* f) { f[0] = bf_lo(v.x); f[1] = bf_hi(v.x); f[2] = bf_lo(v.y); f[3] = bf_hi(v.y); f[4] = bf_lo(v.z); f[5] = bf_hi(v.z); f[6] = bf_lo(v.w); f[7] = bf_hi(v.w); }
__device__ __forceinline__ u32x4 pack8(const float* f) { u32x4 w; w.x = cvt_pk_bf16(f[0], f[1]); w.y = cvt_pk_bf16(f[2], f[3]); w.z = cvt_pk_bf16(f[4], f[5]); w.w = cvt_pk_bf16(f[6], f[7]); return w; }

__device__ __forceinline__ void pool_prep(const bf16_t* CU, bf16_t* PO, int G, int bid, int tid) {
    const int cv = tid & 127, sub = tid >> 7;
    const int grp = cv >> 5, w = 2 << grp;
    for (int c = bid * 4 + sub; c < MROWS / 32; c += G * 4) {
        const int m0 = c * 32, s0 = m0 & (SEQ - 1);
        const bf16_t* up = CU + (size_t)m0 * 2048 + 1024 + cv * 8;
        float sum[8];
#pragma unroll
        for (int i = 0; i < 8; ++i) sum[i] = 0.f;
        if (s0 > 0) for (int k = 1; k < w; ++k) { float f[8]; unpack8(*(const u32x4*)(up - (size_t)k * 2048), f);
#pragma unroll
            for (int i = 0; i < 8; ++i) sum[i] += f[i]; }
#pragma unroll 8
        for (int t = 0; t < 32; ++t) {
            const int s = s0 + t; float f[8], o[8]; unpack8(*(const u32x4*)(up + (size_t)t * 2048), f);
            const float inv = 1.0f / (float)((s + 1) < w ? (s + 1) : w);
#pragma unroll
            for (int i = 0; i < 8; ++i) { sum[i] += f[i]; o[i] = sum[i] * inv - f[i]; }
            *(u32x4*)(PO + (size_t)(m0 + t) * 1024 + cv * 8) = pack8(o);
            if (s - w + 1 >= 0) { float r[8]; unpack8(*(const u32x4*)(up + (long)(t - w + 1) * 2048), r);
#pragma unroll
                for (int i = 0; i < 8; ++i) sum[i] -= r[i]; }
        }
    }
}

__device__ __forceinline__ void conv_phase(const bf16_t* VB, const bf16_t* BG, const float* cw, bf16_t* Gout, int G, int bid, int tid) {
    const int cv = tid & 255, sub = tid >> 8;
    float w0[8], w1[8], w2[8];
#pragma unroll
    for (int i = 0; i < 8; ++i) { w0[i] = cw[cv * 8 + i]; w1[i] = cw[2048 + cv * 8 + i]; w2[i] = cw[4096 + cv * 8 + i]; }
    for (int c = bid * 2 + sub; c < MROWS / 32; c += G * 2) {
        const int m0 = c * 32, s0 = m0 & (SEQ - 1);
        const bf16_t* vp = VB + (size_t)m0 * 2048 + cv * 8; const bf16_t* bp = BG + (size_t)m0 * 2048 + cv * 8;
        float v1[8], v2[8];
#pragma unroll
        for (int i = 0; i < 8; ++i) { v1[i] = 0.f; v2[i] = 0.f; }
        if (s0 > 0) { unpack8(*(const u32x4*)(vp - 2048), v1); unpack8(*(const u32x4*)(vp - 2 * 2048), v2); }
#pragma unroll 8
        for (int t = 0; t < 32; ++t) {
            float bb[8], vv[8], o[8];
            unpack8(*(const u32x4*)(bp + (size_t)t * 2048), bb); unpack8(*(const u32x4*)(vp + (size_t)t * 2048), vv);
#pragma unroll
            for (int i = 0; i < 8; ++i) { const float v = vv[i]; o[i] = bb[i] * (w0[i] * v2[i] + w1[i] * v1[i] + w2[i] * v); v2[i] = v1[i]; v1[i] = v; }
            *(u32x4*)(Gout + (size_t)(m0 + t) * 2048 + cv * 8) = pack8(o);
        }
    }
}

__device__ __forceinline__ void qk_prep(bf16_t* MIX, bf16_t* QROPE, bf16_t* KV, const bf16_t* KR, bf16_t* KROPE, const float* gq, const float* gk, const float* rope, int gw, int NGW, int lane) {
    const int h = lane >> 3, j = lane & 7;
    float gqn[16], gqr[8], gkn[16], gkr[8];
#pragma unroll
    for (int i = 0; i < 16; ++i) { gqn[i] = gq[j * 16 + i]; gkn[i] = gk[j * 16 + i]; }
#pragma unroll
    for (int i = 0; i < 8; ++i) { gqr[i] = gq[128 + j * 8 + i]; gkr[i] = gk[128 + j * 8 + i]; }
#pragma unroll 2
    for (int m = gw; m < MROWS; m += NGW) {
        float cs[8], sn[8];
        { const float* rp = rope + (size_t)m * 64 + 8 * (j & 3);
#pragma unroll
          for (int i = 0; i < 8; ++i) { cs[i] = rp[i]; sn[i] = rp[32 + i]; } }
        const float sgn = (j < 4) ? -1.f : 1.f;
        {
            bf16_t* pn = KV + (size_t)m * 1024 + h * 128 + j * 16; const bf16_t* pr = KR + (size_t)m * 256 + j * 8;
            float a[16], r[8]; unpack8(*(const u32x4*)pn, a); unpack8(*(const u32x4*)(pn + 8), a + 8); unpack8(*(const u32x4*)pr, r);
            float s = 0.f;
#pragma unroll
            for (int i = 0; i < 16; ++i) s += a[i] * a[i];
#pragma unroll
            for (int i = 0; i < 8; ++i) s += r[i] * r[i];
            s += shx(s, 1, lane); s += shx(s, 2, lane); s += shx(s, 4, lane);
            const float rs = 1.0f / sqrtf(s * (1.0f / 192.0f) + RMS_EPS);
#pragma unroll
            for (int i = 0; i < 16; ++i) a[i] = a[i] * rs * gkn[i];
            float o[8];
#pragma unroll
            for (int i = 0; i < 8; ++i) { const float own = r[i] * rs * gkr[i]; const float oth = shx(own, 4, lane); o[i] = own * cs[i] + sgn * oth * sn[i]; }
            *(u32x4*)pn = pack8(a); *(u32x4*)(pn + 8) = pack8(a + 8); *(u32x4*)(KROPE + (size_t)m * 512 + h * 64 + j * 8) = pack8(o);
        }
    }
}

__device__ __forceinline__ void vt_transpose(const bf16_t* KV, bf16_t* VT, LAS unsigned char* lds, int G, int bid, int tid) {
    LAS bf16_t* T0 = (LAS bf16_t*)lds;
    u32x4 v0, v1; int buf = 0;
#define VT_LOAD(it_) do { const int bh_ = (it_) >> 6, tb_ = (it_) & 63, b_ = bh_ >> 3, h_ = bh_ & 7; \
        v0 = *(const u32x4*)(KV + ((size_t)b_ * SEQ + 64 * tb_ + (tid >> 4)) * 2048 + 1024 + h_ * 128 + (tid & 15) * 8); \
        v1 = *(const u32x4*)(KV + ((size_t)b_ * SEQ + 64 * tb_ + 32 + (tid >> 4)) * 2048 + 1024 + h_ * 128 + (tid & 15) * 8); } while (0)
    if (bid < 64 * 64) VT_LOAD(bid);
    for (int it = bid; it < 64 * 64; it += G) {
        LAS bf16_t* T = T0 + buf * (64 * 136);
        *(LAS u32x4*)(T + (tid >> 4) * 136 + (tid & 15) * 8) = v0; *(LAS u32x4*)(T + (32 + (tid >> 4)) * 136 + (tid & 15) * 8) = v1;
        __syncthreads();
        if (it + G < 64 * 64) VT_LOAD(it + G);
        const int bh = it >> 6, tb = it & 63;
#pragma unroll
        for (int k = 0; k < 2; ++k) { const int c = tid + 512 * k, dv = c >> 3, tc = c & 7;
            unsigned short e[8];
#pragma unroll
            for (int i = 0; i < 8; ++i) e[i] = T[(8 * tc + i) * 136 + dv];
            u32x4 w; w.x = e[0] | ((unsigned)e[1] << 16); w.y = e[2] | ((unsigned)e[3] << 16); w.z = e[4] | ((unsigned)e[5] << 16); w.w = e[6] | ((unsigned)e[7] << 16);
            *(u32x4*)(VT + ((size_t)bh * 128 + dv) * SEQ + 64 * tb + 8 * tc) = w; }
        buf ^= 1;
    }
#undef VT_LOAD
    __syncthreads();
}

__device__ __forceinline__ int crow(int r, int hi) { return (r & 3) + 8 * (r >> 2) + 4 * hi; }
constexpr int AT_KROW = 400, AT_VROW = 144, AT_KB = 64 * AT_KROW, AT_VB = 128 * AT_VROW, AT_BUF = AT_KB + AT_VB, AT_WSF = 2 * AT_BUF;

__device__ __forceinline__ void attn_unit(int b, int h, int qb, bf16_t* MIX, const bf16_t* QROPE, const bf16_t* KV, const bf16_t* KROPE, const bf16_t* VT, const float* gq, const float* rope, LAS unsigned char* lds, int wv) {
    const int tid = fresh_tid(wv), lane = tid & 63, w = __builtin_amdgcn_readfirstlane(tid >> 6), r32 = lane & 31, hi = lane >> 5;
    const size_t row0 = (size_t)b * SEQ;
    const int qw = qb * 256 + ((w < 4) ? w : 11 - w) * 32;
    bf16x8 qf[12];
    { const bf16_t* qn = MIX + (row0 + qw + r32) * 2048 + h * 128 + hi * 8;
#pragma unroll
      for (int ks = 0; ks < 8; ++ks) qf[ks] = *(const bf16x8*)(qn + 16 * ks);
      const bf16_t* qr = QROPE + (row0 + qw + r32) * 512 + h * 64 + hi * 8;
#pragma unroll
      for (int ks = 0; ks < 4; ++ks) qf[8 + ks] = *(const bf16x8*)(qr + 16 * ks); }
    const int kc0 = tid, kc1 = tid + 512;
    const bf16_t* ksrc0 = KV + (row0 + (kc0 >> 4)) * 1024 + h * 128 + (kc0 & 15) * 8;
    const bf16_t* ksrc1 = KV + (row0 + (kc1 >> 4)) * 1024 + h * 128 + (kc1 & 15) * 8;
    const bf16_t* ksrc2 = KROPE + (row0 + (tid >> 3)) * 512 + h * 64 + (tid & 7) * 8;
    const bf16_t* vsrc0 = VT + ((size_t)(b * 8 + h) * 128 + (kc0 >> 3)) * SEQ + (kc0 & 7) * 8;
    const bf16_t* vsrc1 = VT + ((size_t)(b * 8 + h) * 128 + (kc1 >> 3)) * SEQ + (kc1 & 7) * 8;
    const int kd0 = (kc0 >> 4) * AT_KROW + (kc0 & 15) * 16, kd1 = (kc1 >> 4) * AT_KROW + (kc1 & 15) * 16, kd2 = (tid >> 3) * AT_KROW + 256 + (tid & 7) * 16;
    const int vd0 = AT_KB + (kc0 >> 3) * AT_VROW + (kc0 & 7) * 16, vd1 = AT_KB + (kc1 >> 3) * AT_VROW + (kc1 & 7) * 16;
    u32x4 s0, s1, s2, s3, s4;
#define AT_GLOAD(t) do { s0 = *(const u32x4*)(ksrc0 + (size_t)(t) * 64 * 1024); s1 = *(const u32x4*)(ksrc1 + (size_t)(t) * 64 * 1024); s2 = *(const u32x4*)(ksrc2 + (size_t)(t) * 64 * 512); \
        s3 = *(const u32x4*)(vsrc0 + (t) * 64); s4 = *(const u32x4*)(vsrc1 + (t) * 64); } while (0)
#define AT_LSTORE(buf) do { LAS unsigned char* bb = lds + (buf) * AT_BUF; *(LAS u32x4*)(bb + kd0) = s0; *(LAS u32x4*)(bb + kd1) = s1; *(LAS u32x4*)(bb + kd2) = s2; *(LAS u32x4*)(bb + vd0) = s3; *(LAS u32x4*)(bb + vd1) = s4; } while (0)
    AT_GLOAD(0);
    __builtin_amdgcn_sched_barrier(0);
    {
        f32x4 gn[8][2], gr1[2][2], gr2[2][2], csv[2][2], snv[2][2];
        const float* rp = rope + (row0 + qw + r32) * 64;
#pragma unroll
        for (int ks = 0; ks < 8; ++ks) { gn[ks][0] = *(const f32x4*)(gq + 16 * ks + 8 * hi); gn[ks][1] = *(const f32x4*)(gq + 16 * ks + 8 * hi + 4); }
        __builtin_amdgcn_sched_barrier(0);
        float ssq = 0.f;
#pragma unroll
        for (int ks = 0; ks < 12; ++ks) { float f[8]; unpack8(__builtin_bit_cast(u32x4, qf[ks]), f);
#pragma unroll
            for (int e = 0; e < 8; ++e) ssq += f[e] * f[e]; }
        ssq = sum_x32(ssq);
        const float rs = (1.0f / sqrtf(ssq * (1.0f / 192.0f) + RMS_EPS)) * QSCALE;
#pragma unroll
        for (int ks = 0; ks < 8; ++ks) { float f[8]; unpack8(__builtin_bit_cast(u32x4, qf[ks]), f);
#pragma unroll
            for (int e = 0; e < 8; ++e) f[e] = f[e] * rs * gn[ks][e >> 2][e & 3];
            qf[ks] = __builtin_bit_cast(bf16x8, pack8(f)); }
        __builtin_amdgcn_sched_barrier(0);
#pragma unroll
        for (int j = 0; j < 2; ++j) { const int i0 = 16 * j + 8 * hi;
            gr1[j][0] = *(const f32x4*)(gq + 128 + i0); gr1[j][1] = *(const f32x4*)(gq + 128 + i0 + 4); gr2[j][0] = *(const f32x4*)(gq + 160 + i0); gr2[j][1] = *(const f32x4*)(gq + 160 + i0 + 4);
            csv[j][0] = *(const f32x4*)(rp + i0); csv[j][1] = *(const f32x4*)(rp + i0 + 4); snv[j][0] = *(const f32x4*)(rp + 32 + i0); snv[j][1] = *(const f32x4*)(rp + 32 + i0 + 4); }
        __builtin_amdgcn_sched_barrier(0);
#pragma unroll
        for (int j = 0; j < 2; ++j) { float x1[8], x2[8], o1[8], o2[8];
            unpack8(__builtin_bit_cast(u32x4, qf[8 + j]), x1); unpack8(__builtin_bit_cast(u32x4, qf[10 + j]), x2);
#pragma unroll
            for (int e = 0; e < 8; ++e) { const float a1 = x1[e] * rs * gr1[j][e >> 2][e & 3], a2 = x2[e] * rs * gr2[j][e >> 2][e & 3], cs = csv[j][e >> 2][e & 3], sn = snv[j][e >> 2][e & 3];
                o1[e] = a1 * cs - a2 * sn; o2[e] = a2 * cs + a1 * sn; }
            qf[8 + j] = __builtin_bit_cast(bf16x8, pack8(o1)); qf[10 + j] = __builtin_bit_cast(bf16x8, pack8(o2)); }
    }
    f32x16 o[4];
#pragma unroll
    for (int d = 0; d < 4; ++d)
#pragma unroll
        for (int r = 0; r < 16; ++r) o[d][r] = 0.f;
    float mref = 0.f, lrun = 0.f;
    f32x16 negm;
#pragma unroll
    for (int r = 0; r < 16; ++r) negm[r] = 0.f;
    const int NT = 4 * (qb + 1);
    AT_LSTORE(0);
    const int pi = 16 * (r32 >> 4) + 8 * ((r32 >> 2) & 1) + 4 * ((r32 >> 3) & 1) + (r32 & 3);
    LAS float* wsf = (LAS float*)(lds + AT_WSF) + w * 32;
    const int qabs = qw + r32;
    for (int t = 0; t < NT; ++t) {
        __syncthreads();
        if (t + 1 < NT) AT_GLOAD(t + 1);
        if (64 * t <= qw + 31) {
            const LAS unsigned char* kb = lds + (t & 1) * AT_BUF + pi * AT_KROW + hi * 16;
            const LAS unsigned char* vb = lds + (t & 1) * AT_BUF + AT_KB + r32 * AT_VROW + hi * 16;
            __builtin_amdgcn_sched_barrier(0);
            f32x16 p0, p1;
#pragma unroll
            for (int ks = 0; ks < 12; ++ks) {
                const bf16x8 k0 = *(const LAS bf16x8*)(kb + ks * 32);
                const bf16x8 k1 = *(const LAS bf16x8*)(kb + 32 * AT_KROW + ks * 32);
                p0 = __builtin_amdgcn_mfma_f32_32x32x16_bf16(k0, qf[ks], ks == 0 ? negm : p0, 0, 0, 0);
                p1 = __builtin_amdgcn_mfma_f32_32x32x16_bf16(k1, qf[ks], ks == 0 ? negm : p1, 0, 0, 0);
            }
            __builtin_amdgcn_sched_group_barrier(0x100, 12, 0);
#pragma unroll
            for (int i = 0; i < 6; ++i) { __builtin_amdgcn_sched_group_barrier(0x008, 2, 0); __builtin_amdgcn_sched_group_barrier(0x100, 2, 0); }
            __builtin_amdgcn_sched_group_barrier(0x008, 12, 0);
            __builtin_amdgcn_sched_barrier(0);
            if (64 * t + 63 > qw) {
#pragma unroll
                for (int r = 0; r < 16; ++r) { const int key = 64 * t + 16 * (r >> 3) + 8 * hi + (r & 7);
                    if (key > qabs) p0[r] = -INFINITY; if (key + 32 > qabs) p1[r] = -INFINITY; }
            }
            float rm = fmaxf(p0[0], p1[0]);
#pragma unroll
            for (int r = 1; r < 16; ++r) rm = fmaxf(rm, fmaxf(p0[r], p1[r]));
            rm = max_x32(rm);
            if (t == 0 || __any(rm > 8.0f)) {
                const float dl = (t == 0) ? rm : fmaxf(rm, 0.f);
                mref += dl;
#pragma unroll
                for (int r = 0; r < 16; ++r) { p0[r] -= dl; p1[r] -= dl; negm[r] = -mref; }
                const float alpha = __builtin_amdgcn_exp2f(-dl);
                lrun *= alpha;
                if (t > 0) {
                    if (hi == 0) wsf[r32] = alpha;
                    asm volatile("s_waitcnt lgkmcnt(0)" ::: "memory");
                    float al[16];
#pragma unroll
                    for (int r = 0; r < 16; ++r) al[r] = wsf[crow(r, hi)];
#pragma unroll
                    for (int d = 0; d < 4; ++d)
#pragma unroll
                        for (int r = 0; r < 16; ++r) o[d][r] *= al[r];
                    asm volatile("s_waitcnt lgkmcnt(0)" ::: "memory");
                }
            }
            {
                typedef float f32x2 __attribute__((ext_vector_type(2)));
                f32x2 rs2 = (f32x2){0.f, 0.f};
#pragma unroll
                for (int r = 0; r < 16; r += 2) {
                    p0[r] = __builtin_amdgcn_exp2f(p0[r]); p0[r + 1] = __builtin_amdgcn_exp2f(p0[r + 1]); p1[r] = __builtin_amdgcn_exp2f(p1[r]); p1[r + 1] = __builtin_amdgcn_exp2f(p1[r + 1]);
                    rs2 += (f32x2){p0[r], p0[r + 1]}; rs2 += (f32x2){p1[r], p1[r + 1]};
                }
                lrun += rs2.x + rs2.y;
            }
            bf16x8 pa[4];
            { u32x4 t0, t1, t2, t3;
              t0.x = cvt_pk_bf16(p0[0], p0[1]); t0.y = cvt_pk_bf16(p0[2], p0[3]); t0.z = cvt_pk_bf16(p0[4], p0[5]); t0.w = cvt_pk_bf16(p0[6], p0[7]);
              t1.x = cvt_pk_bf16(p0[8], p0[9]); t1.y = cvt_pk_bf16(p0[10], p0[11]); t1.z = cvt_pk_bf16(p0[12], p0[13]); t1.w = cvt_pk_bf16(p0[14], p0[15]);
              t2.x = cvt_pk_bf16(p1[0], p1[1]); t2.y = cvt_pk_bf16(p1[2], p1[3]); t2.z = cvt_pk_bf16(p1[4], p1[5]); t2.w = cvt_pk_bf16(p1[6], p1[7]);
              t3.x = cvt_pk_bf16(p1[8], p1[9]); t3.y = cvt_pk_bf16(p1[10], p1[11]); t3.z = cvt_pk_bf16(p1[12], p1[13]); t3.w = cvt_pk_bf16(p1[14], p1[15]);
              pa[0] = __builtin_bit_cast(bf16x8, t0); pa[1] = __builtin_bit_cast(bf16x8, t1); pa[2] = __builtin_bit_cast(bf16x8, t2); pa[3] = __builtin_bit_cast(bf16x8, t3); }
            __builtin_amdgcn_sched_barrier(0);
#pragma unroll
            for (int j = 0; j < 4; ++j)
#pragma unroll
                for (int d = 0; d < 4; ++d) {
                    const bf16x8 vf = *(const LAS bf16x8*)(vb + d * 32 * AT_VROW + j * 32);
                    o[d] = __builtin_amdgcn_mfma_f32_32x32x16_bf16(pa[j], vf, o[d], 0, 0, 0);
                }
            __builtin_amdgcn_sched_group_barrier(0x100, 8, 0);
#pragma unroll
            for (int i = 0; i < 4; ++i) { __builtin_amdgcn_sched_group_barrier(0x008, 2, 0); __builtin_amdgcn_sched_group_barrier(0x100, 2, 0); }
            __builtin_amdgcn_sched_group_barrier(0x008, 8, 0);
            __builtin_amdgcn_sched_barrier(0);
        }
        if (t + 1 < NT) AT_LSTORE((t + 1) & 1);
    }
#undef AT_GLOAD
#undef AT_LSTORE
    lrun = sum_x32(lrun);
    if (hi == 0) wsf[r32] = 1.0f / lrun;
    asm volatile("s_waitcnt lgkmcnt(0)" ::: "memory");
    float rl[16];
#pragma unroll
    for (int r = 0; r < 16; ++r) rl[r] = wsf[crow(r, hi)];
    asm volatile("s_waitcnt lgkmcnt(0)" ::: "memory");
#pragma unroll
    for (int r = 0; r < 16; ++r) {
        bf16_t* op = MIX + (row0 + qw + crow(r, hi)) * 2048 + h * 128 + r32;
#pragma unroll
        for (int d = 0; d < 4; ++d) op[d * 32] = (bf16_t)(cvt_pk_bf16(o[d][r] * rl[r], 0.f) & 0xffffu);
    }
    __syncthreads();
}

__device__ __forceinline__ void attn_phase(bf16_t* MIX, const bf16_t* QROPE, const bf16_t* KV, const bf16_t* KROPE, const bf16_t* VT, const float* gq, const float* rope, LAS unsigned char* lds, int G, int bid, int wv) {
    for (int r = 0;; ++r) {
        const int idx = r * G + ((r & 1) ? (G - 1 - bid) : bid);
        if (r * G >= 1024) break;
        if (idx >= 1024) continue;
        const int qb = 15 - (idx >> 6), bh = idx & 63;
        attn_unit(bh >> 3, bh & 7, qb, MIX, QROPE, KV, KROPE, VT, gq, rope, lds, wv);
    }
}

#define XB_TMO      128
#define XB_XCNT(j)  (256  + 64 * (j))
#define XB_XSUB(j)  (1280 + 64 * (j))
#define XB_XGEN(j)  (2304 + 64 * (j))
#define XB_TOP      3328
#define XB_TOPGEN   3392
#define XCD_BAR_WORDS 3456
#define XB_SPIN_CAP (1u << 18)
constexpr int MISC_OFF = 131072 + 320;
__device__ __forceinline__ unsigned xb_ld(unsigned* p)              { return __hip_atomic_load(p, __ATOMIC_RELAXED, __HIP_MEMORY_SCOPE_AGENT); }
__device__ __forceinline__ unsigned xb_add(unsigned* p, unsigned v) { return __hip_atomic_fetch_add(p, v, __ATOMIC_RELAXED, __HIP_MEMORY_SCOPE_AGENT); }
__device__ __forceinline__ unsigned xb_xcc_id() { return (unsigned)__builtin_amdgcn_s_getreg((3 << 11) | 20) & 0xFu; }
#define XB_SPIN(cond, bar) do { unsigned _sp = 0; while (cond) { __builtin_amdgcn_s_sleep(1); \
    if ((++_sp & 255u) == 0u) { if (xb_ld(&(bar)[XB_TMO])) break; if (_sp > XB_SPIN_CAP) { atomicAdd(&(bar)[XB_TMO], 1u); break; } } } } while (0)
__device__ __forceinline__ void xcd_barrier_complete(unsigned* bar, unsigned x, unsigned G, unsigned& nloc, unsigned& nx) {
    unsigned sum, cnt, mine, sp = 0u;
    for (;;) {
        sum = 0u; cnt = 0u; mine = 0u;
#pragma unroll
        for (unsigned j = 0; j < 16; ++j) { const unsigned c = xb_ld(&bar[XB_XCNT(j)]); sum += c; cnt += (c > 0u) ? 1u : 0u; mine = (j == x) ? c : mine; }
        if (sum == G) break;
        __builtin_amdgcn_s_sleep(1);
        if ((++sp & 255u) == 0u) { if (xb_ld(&bar[XB_TMO])) break; if (sp > XB_SPIN_CAP) { atomicAdd(&bar[XB_TMO], 1u); break; } }
    }
    nloc = mine > 0u ? mine : 1u; nx = cnt > 0u ? cnt : 1u;
}
__device__ __forceinline__ void xcd_barrier(unsigned* bar, volatile LAS unsigned* st, bool t0, unsigned G) {
    asm volatile("s_waitcnt vmcnt(0)" ::: "memory");
    __syncthreads();
    if (t0) {
        const unsigned x = xb_xcc_id();
        __builtin_amdgcn_s_waitcnt(0);
        unsigned nloc = st[0], nx = st[1];
        if (nloc == 0u) { xcd_barrier_complete(bar, x, G, nloc, nx); st[0] = nloc; st[1] = nx; }
        const unsigned old = xb_add(&bar[XB_XSUB(x)], 1u);
        const unsigned gen = old / nloc;
        if (old + 1u == (gen + 1u) * nloc) {
            __builtin_amdgcn_fence(__ATOMIC_RELEASE, "agent");
            asm volatile("s_waitcnt vmcnt(0)" ::: "memory");
            const unsigned og = xb_add(&bar[XB_TOP], 1u);
            const unsigned tg = og / nx;
            if (og + 1u == (tg + 1u) * nx) xb_add(&bar[XB_TOPGEN], 1u);
            else XB_SPIN(xb_ld(&bar[XB_TOPGEN]) == tg, bar);
            __builtin_amdgcn_fence(__ATOMIC_ACQUIRE, "agent");
            xb_add(&bar[XB_XGEN(x)], 1u);
            asm volatile("s_waitcnt vmcnt(0)" ::: "memory");
        } else {
            XB_SPIN(xb_ld(&bar[XB_XGEN(x)]) == gen, bar);
            __builtin_amdgcn_fence(__ATOMIC_ACQUIRE, "agent");
            asm volatile("s_waitcnt vmcnt(0)" ::: "memory");
        }
    }
    __syncthreads();
}

typedef const __attribute__((address_space(4))) Args* KArgsP;
__device__ __forceinline__ KArgsP kargs() { KArgsP p = (KArgsP)__builtin_amdgcn_kernarg_segment_ptr(); asm volatile("" : "+s"(p)); return p; }
#define PH_SETUP() asm volatile("" : "+s"(G), "+s"(bid)); const KArgsP ka = kargs(); unsigned char* const ws = ka->ws; const int tid = fresh_tid(wv); const int lane = tid & 63, wave = wv; (void)lane; (void)wave
#define WSP(T, off) ((T*)(ws + (off)))

__device__ __forceinline__ void ph_prologue(LAS unsigned char* lds, int G, int bid, int wv) {
    PH_SETUP();
    Args a;
    a.x = ka->x; a.pos = ka->pos; a.mix_g = ka->mix_g; a.mlp_g = ka->mlp_g; a.w_up = ka->w_up; a.w_down = ka->w_down; a.e_w_in = ka->e_w_in; a.e_qa_g = ka->e_qa_g; a.e_kva_g = ka->e_kva_g;
    a.e_w_uq = ka->e_w_uq; a.e_w_ukv = ka->e_w_ukv; a.e_qn_g = ka->e_qn_g; a.e_kn_g = ka->e_kn_g; a.e_pool_w = ka->e_pool_w; a.e_pool_s = ka->e_pool_s; a.e_w_out = ka->e_w_out;
    a.o_w_in = ka->o_w_in; a.o_conv_w = ka->o_conv_w; a.o_w_out = ka->o_w_out; a.out = ka->out; a.ws = ws;
    prologue(a, lds, bid * 8 + wave, G * 8, lane, wave);
}
__device__ __forceinline__ void ph_e1(LAS unsigned char* lds, int e, int G, int bid, int wv) {
    asm volatile("" : "+s"(e));
    PH_SETUP();
    pg8::EpiB<32, 2048, 0, 4, 8, 2048, 256> E{WSP(bf16_t, H_CU), WSP(bf16_t, H_KR), WSP(float, WS_SSQX), WSP(float, WS_SSQC)};
    pg8::gemm_phase<NIN_E, 2048, 2048, 2048, 0>(lds, WSP(bf16_t, WS_XB), WSP(bf16_t, W_INE) + (size_t)e * NIN_E * DM, G, bid, wv, E);
}
__device__ __forceinline__ void ph_e2a(int G, int bid, int wv) { PH_SETUP(); pool_prep(WSP(bf16_t, H_CU), WSP(bf16_t, H_POOLED), G, bid, tid); }
__device__ __forceinline__ void ph_e2b(LAS unsigned char* lds, int e, int G, int bid, int wv) {
    asm volatile("" : "+s"(e));
    PH_SETUP();
    pg8::EpiB<8, 512, 0, 0, 4, 2048, 512> E{WSP(bf16_t, H_MIX), WSP(bf16_t, H_QROPE), WSP(float, WS_SSQC), nullptr};
    pg8::gemm_phase<1536, 512, 2048, 512, 0>(lds, WSP(bf16_t, H_CU), WSP(bf16_t, W_UQ) + (size_t)e * 1536 * 512, G, bid, wv, E);
}
__device__ __forceinline__ void ph_e2c(LAS unsigned char* lds, int e, int G, int bid, int wv) {
    asm volatile("" : "+s"(e));
    PH_SETUP();
    pg8::EpiKV E{WSP(bf16_t, H_KV), WSP(bf16_t, H_VT), WSP(float, WS_SSQC) + (size_t)8 * MROWS};
    pg8::gemm_phase<2048, 512, 2048, 512, 0>(lds, WSP(bf16_t, H_CU) + 512, WSP(bf16_t, W_UKV) + (size_t)e * 2048 * 512, G, bid, wv, E);
}
__device__ __forceinline__ void ph_e3a(LAS unsigned char* lds, int e, int G, int bid, int wv) {
    asm volatile("" : "+s"(e));
    PH_SETUP();
    pg8::EpiB<0, 1, 0, 0, 99, 2048, 0> E{WSP(bf16_t, H_MIX) + 1024, nullptr, nullptr, nullptr};
    pg8::gemm_phase<1024, 256, 1024, 256, 512>(lds, WSP(bf16_t, H_POOLED), WSP(bf16_t, W_POOL) + (size_t)e * 4 * 65536, G, bid, wv, E);
}
__device__ __forceinline__ void ph_e3b(int e, int G, int bid, int wv) {
    asm volatile("" : "+s"(e));
    PH_SETUP();
    qk_prep(WSP(bf16_t, H_MIX), WSP(bf16_t, H_QROPE), WSP(bf16_t, H_KV), WSP(bf16_t, H_KR), WSP(bf16_t, H_KROPE), ka->e_qn_g + e * 192, ka->e_kn_g + e * 192, WSP(float, WS_ROPE), bid * 8 + wave, G * 8, lane);
}
__device__ __forceinline__ void ph_e3c(LAS unsigned char* lds, int G, int bid, int wv) { PH_SETUP(); vt_transpose(WSP(bf16_t, H_KV), WSP(bf16_t, H_VT), lds, G, bid, tid); }
__device__ __forceinline__ void ph_e4(LAS unsigned char* lds, int e, int G, int bid, int wv) {
    asm volatile("" : "+s"(e));
    PH_SETUP();
    attn_phase(WSP(bf16_t, H_MIX), WSP(bf16_t, H_QROPE), WSP(bf16_t, H_KV), WSP(bf16_t, H_KROPE), WSP(bf16_t, H_VT), ka->e_qn_g + e * 192, WSP(float, WS_ROPE), lds, G, bid, wv);
}
__device__ __forceinline__ void ph_o1(LAS unsigned char* lds, int o, int G, int bid, int wv) {
    asm volatile("" : "+s"(o));
    PH_SETUP();
    pg8::EpiCU E{WSP(bf16_t, H_VB), WSP(bf16_t, H_BG), WSP(float, WS_SSQX)};
    pg8::gemm_phase<6144, 2048, 2048, 2048, 0, false, 4>(lds, WSP(bf16_t, WS_XB), WSP(bf16_t, W_INO) + (size_t)o * 6144 * DM, G, bid, wv, E);
}
__device__ __forceinline__ void ph_o2(int o, int G, int bid, int wv) {
    asm volatile("" : "+s"(o));
    PH_SETUP(); conv_phase(WSP(bf16_t, H_VB), WSP(bf16_t, H_BG), ka->o_conv_w + (size_t)o * 3 * DM, WSP(bf16_t, H_G), G, bid, tid); }
__device__ __forceinline__ void ph_mixout(LAS unsigned char* lds, int l, int G, int bid, int wv) {
    asm volatile("" : "+s"(l));
    PH_SETUP();
    const int e = l >> 1;
    const bf16_t* A = (l & 1) ? WSP(bf16_t, H_G) : WSP(bf16_t, H_MIX);
    const bf16_t* B = ((l & 1) ? WSP(bf16_t, W_OUTO) : WSP(bf16_t, W_OUTE)) + (size_t)e * DM * DM;
    float* out = ka->out;
    pg8::EpiR E{(l == 0) ? ka->x : (const float*)out, out, WSP(bf16_t, WS_XB), WSP(float, WS_SSQX), 1.0f};
    pg8::gemm_phase<2048, 2048, 2048, 2048, 0, false, 4>(lds, A, B, G, bid, wv, E);
}
__device__ __forceinline__ void ph_up(LAS unsigned char* lds, int l, int G, int bid, int wv) {
    asm volatile("" : "+s"(l));
    PH_SETUP();
    pg8::EpiB<32, 2048, 1, 0, 99, 8192, 0> E{WSP(bf16_t, WS_H), nullptr, WSP(float, WS_SSQX), nullptr};
    pg8::gemm_phase<8192, 2048, 2048, 2048, 0, false, 4>(lds, WSP(bf16_t, WS_XB), WSP(bf16_t, W_UP) + (size_t)l * DM * FF, G, bid, wv, E);
}
__device__ __forceinline__ void ph_down(LAS unsigned char* lds, int l, int G, int bid, int wv) {
    asm volatile("" : "+s"(l));
    PH_SETUP();
    float* out = ka->out;
    pg8::EpiR E{out, out, WSP(bf16_t, WS_XB), WSP(float, WS_SSQX), 1.0f};
    pg8::gemm_phase<2048, 8192, 8192, 8192, 0, false, 4>(lds, WSP(bf16_t, WS_H), WSP(bf16_t, W_DOWN) + (size_t)l * DM * FF, G, bid, wv, E);
}
__device__ __forceinline__ void ph_up_f8(LAS unsigned char* lds, int l, int G, int bid, int wv) {
    asm volatile("" : "+s"(l));
    PH_SETUP();
    pg8::EpiB<32, 2048, 1, 0, 99, 8192, 0, true> E{WSP(bf16_t, WS_H), nullptr, WSP(float, WS_SSQX), nullptr};
    pg8::gemm_phase<8192, 2048, 2048, 2048, 0, false, 4>(lds, WSP(bf16_t, WS_XB), WSP(bf16_t, W_UP) + (size_t)l * DM * FF, G, bid, wv, E);
}
__device__ __forceinline__ void ph_down_f8(LAS unsigned char* lds, int l, int G, int bid, int wv) {
    asm volatile("" : "+s"(l));
    PH_SETUP();
    float* out = ka->out;
    pg8::EpiR E{out, out, WSP(bf16_t, WS_XB), WSP(float, WS_SSQX), F8_UNSCALE};
    pg8::gemm_phase<2048, 4096, 4096, 4096, 0, true>(lds, WSP(bf16_t, WS_H), WSP(bf16_t, W_DOWN) + (size_t)l * DM * FF, G, bid, wv, E);
}

__global__ void __launch_bounds__(512, 2) mk_fwd(Args a_) {
    extern __shared__ __attribute__((aligned(16))) unsigned char lds_raw[];
    LAS unsigned char* lds = (LAS unsigned char*)lds_raw;
    cg::grid_group grid = cg::this_grid();
    const int G = gridDim.x, bid = blockIdx.x, wv = __builtin_amdgcn_readfirstlane((int)threadIdx.x >> 6);
    if (bid == 0) {
        unsigned* bar0 = (unsigned*)kargs()->ws;
        for (int i = fresh_tid(wv); i < XCD_BAR_WORDS; i += 512) bar0[i] = 0u;
    }
    ph_prologue(lds, G, bid, wv);
    grid.sync();
    { const bool t0 = fresh_tid(wv) == 0;
      volatile LAS unsigned* st = (volatile LAS unsigned*)(lds + MISC_OFF);
      if (t0) { st[0] = 0u; st[1] = 0u; (void)xb_add(&((unsigned*)kargs()->ws)[XB_XCNT(xb_xcc_id())], 1u); }
      __syncthreads(); }
#define GSYNC() xcd_barrier((unsigned*)kargs()->ws, (volatile LAS unsigned*)(lds + MISC_OFF), fresh_tid(wv) == 0, (unsigned)G)
    for (int l = 0; l < 4; ++l) {
        const int e = l >> 1;
        if ((l & 1) == 0) {
            ph_e1(lds, e, G, bid, wv); GSYNC();
            ph_e2a(G, bid, wv); ph_e2b(lds, e, G, bid, wv); ph_e2c(lds, e, G, bid, wv); GSYNC();
            ph_e3a(lds, e, G, bid, wv); ph_e3b(e, G, bid, wv); GSYNC();
            ph_e4(lds, e, G, bid, wv); GSYNC();
        } else {
            ph_o1(lds, e, G, bid, wv); GSYNC();
            ph_o2(e, G, bid, wv); GSYNC();
        }
        ph_mixout(lds, l, G, bid, wv); GSYNC();
        if ((FP8_DOWN_MASK >> l) & 1) {
            ph_up_f8(lds, l, G, bid, wv); GSYNC();
            ph_down_f8(lds, l, G, bid, wv);
        } else {
            if (FP8_DOWN_MASK != 15) { ph_up(lds, l, G, bid, wv); GSYNC(); ph_down(lds, l, G, bid, wv); }
        }
        if (l < 3) GSYNC();
    }
}

extern "C" void kernel_launch(void* const* d_in, const int* in_sizes, int n_in, void* d_out, int out_size, void* d_ws, size_t ws_size, hipStream_t stream) {
    static int grid = 0;
    if (grid == 0) {
        if (n_in != 19 || ws_size < WS_END) { fprintf(stderr, "kernel_launch: unexpected n_in %d / ws_size %zu\n", n_in, ws_size); grid = -1; return; }
        int dev = 0, cus = 0, per_cu = 0;
        hipGetDevice(&dev);
        hipDeviceGetAttribute(&cus, hipDeviceAttributeMultiprocessorCount, dev);
        if (hipFuncSetAttribute((const void*)mk_fwd, hipFuncAttributeMaxDynamicSharedMemorySize, LDS_BYTES) != hipSuccess) { fprintf(stderr, "kernel_launch: hipFuncSetAttribute failed\n"); grid = -1; return; }
        if (hipOccupancyMaxActiveBlocksPerMultiprocessor(&per_cu, (const void*)mk_fwd, 512, LDS_BYTES) != hipSuccess || per_cu < 1) { fprintf(stderr, "kernel_launch: occupancy query gave %d\n", per_cu); per_cu = 1; }
        (void)hipGetLastError();
        grid = cus * 1;
        (void)per_cu;
    }
    if (grid < 0) return;
    Args a{};
    a.x = (const float*)d_in[0]; a.pos = (const int*)d_in[1]; a.mix_g = (const float*)d_in[2]; a.mlp_g = (const float*)d_in[3]; a.w_up = (const float*)d_in[4]; a.w_down = (const float*)d_in[5];
    a.e_w_in = (const float*)d_in[6]; a.e_qa_g = (const float*)d_in[7]; a.e_kva_g = (const float*)d_in[8]; a.e_w_uq = (const float*)d_in[9]; a.e_w_ukv = (const float*)d_in[10];
    a.e_qn_g = (const float*)d_in[11]; a.e_kn_g = (const float*)d_in[12]; a.e_pool_w = (const float*)d_in[13]; a.e_pool_s = (const float*)d_in[14]; a.e_w_out = (const float*)d_in[15];
    a.o_w_in = (const float*)d_in[16]; a.o_conv_w = (const float*)d_in[17]; a.o_w_out = (const float*)d_in[18];
    a.out = (float*)d_out; a.ws = (unsigned char*)d_ws;
    void* args[] = {&a};
    hipError_t e = hipLaunchCooperativeKernel((const void*)mk_fwd, dim3(grid), dim3(512), args, LDS_BYTES, stream);
    if (e != hipSuccess) fprintf(stderr, "kernel_launch: cooperative launch failed: %s (grid %d)\n", hipGetErrorString(e), grid);
}
```
